# Optimizing an MI355X kernel written in HIP

```python
import jax, jax.numpy as jnp
from jax import lax
import numpy as np

D_MODEL = 1024
BATCH = 16
SEQ = 256
DEPTH = 2
DEC_BATCH = 2
DEC_SEQ = 2048
PAST_LEN = 256

GRID_W = 64
N_MIXERS = 2
EPS = 1e-6
N_MOD = 9
D_FF = 2816
FFN_RES = 0.5
D_RNN = 1280
RG_BLOCKS = 10
RG_BLOCK = D_RNN // RG_BLOCKS
CONV_W = 4
CONV_PAD_L = (CONV_W - 1) // 2
RG_C = 8.0
GLA_HEADS = 4
GLA_QK = D_MODEL // 2
GLA_V = D_MODEL
GLA_DK = GLA_QK // GLA_HEADS
GLA_DV = GLA_V // GLA_HEADS
GLA_RANK = 16
GLA_TAU = 16.0
GLA_CHUNK = 32
GLA_IN = 2 * GLA_QK + 2 * GLA_V + 2 * GLA_RANK

kernel_name = "hybrid_rglru_gla_diffusion_step"


def rms_norm(x, g):
    xf = x.astype(jnp.float32)
    y = xf * lax.rsqrt(jnp.mean(xf * xf, axis=-1, keepdims=True) + EPS)
    return (y * g.astype(jnp.float32)).astype(x.dtype)


def ada_mod(cvec, w, b):
    m = jax.nn.silu(cvec) @ w + b
    return m.reshape(-1, 1, N_MOD, D_MODEL)


def modulated(x, mod, gains, j):
    return rms_norm(x, gains[j]) * (1.0 + mod[:, :, 3 * j + 1]) + mod[:, :, 3 * j]


def swiglu(h, w_in, w_out):
    g, u = jnp.split(h @ w_in, 2, axis=-1)
    return (jax.nn.silu(g) * u) @ w_out


def half_ffn(x, mod, gains, j, w_in, w_out):
    return x + FFN_RES * mod[:, :, 3 * j + 2] * swiglu(modulated(x, mod, gains, j), w_in, w_out)


def centred_dwconv(x, w, b):
    y = lax.conv_general_dilated(x, w[:, None, :], window_strides=(1,),
                                 padding=[(CONV_PAD_L, CONV_W - 1 - CONV_PAD_L)],
                                 dimension_numbers=('NWC', 'WIO', 'NWC'),
                                 feature_group_count=x.shape[-1])
    return y + b


def rglru_scan(xc, w_a, b_a, w_i, b_i, lam, h0, reverse):
    bsz, t_len, _ = xc.shape
    f32 = jnp.float32
    xf = xc.astype(f32)
    xb = xf.reshape(bsz, t_len, RG_BLOCKS, RG_BLOCK)
    r = jax.nn.sigmoid(jnp.einsum('btnk,nkj->btnj', xb, w_a.astype(f32)).reshape(bsz, t_len, D_RNN) + b_a.astype(f32))
    gi = jax.nn.sigmoid(jnp.einsum('btnk,nkj->btnj', xb, w_i.astype(f32)).reshape(bsz, t_len, D_RNN) + b_i.astype(f32))
    log_a = -RG_C * r * jax.nn.softplus(-lam.astype(f32))
    a = jnp.exp(log_a)
    u = jnp.sqrt(-jnp.expm1(2.0 * log_a)) * (gi * xf)

    def step(h, inp):
        a_t, u_t = inp
        h = a_t * h + u_t
        return h, h

    h_last, hs = lax.scan(step, h0.astype(f32), (a.swapaxes(0, 1), u.swapaxes(0, 1)), reverse=reverse)
    return hs.swapaxes(0, 1), h_last


def rglru_mixer(h, w_in, conv_w, conv_b, w_a, b_a, w_i, b_i, lam, w_out, h0_f, h0_b):
    gate_br, x_br = jnp.split(h @ w_in, 2, axis=-1)
    xc = centred_dwconv(x_br, conv_w, conv_b)
    y_f, s_f = rglru_scan(xc, w_a[0], b_a[0], w_i[0], b_i[0], lam[0], h0_f, False)
    y_b, s_b = rglru_scan(xc, w_a[1], b_a[1], w_i[1], b_i[1], lam[1], h0_b, True)
    y = (y_f + y_b).astype(h.dtype) * jax.nn.gelu(gate_br)
    return y @ w_out, jnp.stack([s_f, s_b], axis=1)


def gla_chunked(q, k, v, log_g, s0):
    bsz, t_len, n_h = q.shape[0], q.shape[1], q.shape[2]
    n_chunks = t_len // GLA_CHUNK

    def chunk(a):
        return a.reshape((bsz, n_chunks, GLA_CHUNK) + a.shape[2:])

    q, k, v, log_g = chunk(q), chunk(k), chunk(v), chunk(log_g)
    b = jnp.cumsum(log_g, axis=2)
    b_last = b[:, :, -1:]
    causal = jnp.tril(jnp.ones((GLA_CHUNK, GLA_CHUNK), dtype=bool))[None, None, :, :, None, None]
    rel = jnp.where(causal, b[:, :, :, None] - b[:, :, None, :], -jnp.inf)
    scores = jnp.einsum('bnihd,bnjhd,bnijhd->bnhij', q, k, jnp.exp(rel))
    o_intra = jnp.einsum('bnhij,bnjhv->bnihv', scores, v)
    u = jnp.einsum('bnchk,bnchv->bnhkv', k * jnp.exp(b_last - b), v)
    a_chunk = jnp.exp(b_last[:, :, 0])

    def step(s, inp):
        a_n, u_n = inp
        return a_n[..., None] * s + u_n, s

    s_final, s_enter = lax.scan(step, s0, (jnp.moveaxis(a_chunk, 1, 0), jnp.moveaxis(u, 1, 0)))
    s_enter = jnp.moveaxis(s_enter, 0, 1)
    o_inter = jnp.einsum('bnchk,bnhkv->bnchv', q * jnp.exp(b), s_enter)
    return (o_intra + o_inter).reshape(bsz, t_len, n_h, v.shape[-1]), s_final


def gla_mixer(h, w_in, w_g2, b_g, g_norm, w_out, s0_f, s0_b):
    bsz, t_len, _ = h.shape
    f32 = jnp.float32
    proj = h @ w_in
    q, k, v, r, z_f, z_b = jnp.split(proj, [GLA_QK, 2 * GLA_QK, 2 * GLA_QK + GLA_V,
                                          2 * GLA_QK + 2 * GLA_V, 2 * GLA_QK + 2 * GLA_V + GLA_RANK], axis=-1)
    q = q.astype(f32).reshape(bsz, t_len, GLA_HEADS, GLA_DK) * (GLA_DK ** -0.5)
    k = k.astype(f32).reshape(bsz, t_len, GLA_HEADS, GLA_DK)
    v = v.astype(f32).reshape(bsz, t_len, GLA_HEADS, GLA_DV)

    def log_gate(z, w2, bias):
        zz = z.astype(f32) @ w2.astype(f32) + bias.astype(f32)
        return (-jax.nn.softplus(-zz) / GLA_TAU).reshape(bsz, t_len, GLA_HEADS, GLA_DK)

    def flip(t):
        return jnp.flip(t, axis=1)

    o_f, s_f = gla_chunked(q, k, v, log_gate(z_f, w_g2[0], b_g[0]), s0_f.astype(f32))
    o_b, s_b = gla_chunked(flip(q), flip(k), flip(v), flip(log_gate(z_b, w_g2[1], b_g[1])), s0_b.astype(f32))
    o = o_f + flip(o_b)
    o = o * lax.rsqrt(jnp.mean(o * o, axis=-1, keepdims=True) + EPS) * g_norm.astype(f32).reshape(GLA_HEADS, GLA_DV)
    o = o.reshape(bsz, t_len, GLA_V).astype(h.dtype) * jax.nn.silu(r)
    return o @ w_out, jnp.stack([s_f, s_b], axis=1)


def to_col_major(x, rows):
    bsz, t_len, d = x.shape
    return x.reshape(bsz, rows, GRID_W, d).swapaxes(1, 2).reshape(bsz, t_len, d)


def from_col_major(x, rows):
    bsz, t_len, d = x.shape
    return x.reshape(bsz, GRID_W, rows, d).swapaxes(1, 2).reshape(bsz, t_len, d)


def setup_inputs(seed: int = 0) -> dict:
    key = jax.random.key(seed)
    ks = iter(jax.random.split(key, 32))
    n_a = (DEPTH + 1) // 2
    n_b = DEPTH // 2
    f32 = jnp.float32

    def nrm(shape, scale):
        return jax.random.normal(next(ks), shape, f32) * scale

    x_prompt = nrm((BATCH, SEQ, D_MODEL), 1.0)
    x_sample = nrm((DEC_BATCH, DEC_SEQ, D_MODEL), 1.0)
    c = nrm((DEC_BATCH, D_MODEL), 1.0)
    state_rglru = nrm((DEC_BATCH, n_a, 2, D_RNN), 1.0)
    state_gla = nrm((DEC_BATCH, n_b, 2, GLA_HEADS, GLA_DK, GLA_DV), 1.0)
    c_ctx = nrm((D_MODEL,), 1.0)
    ada_w = nrm((DEPTH, D_MODEL, N_MOD * D_MODEL), 0.5 * D_MODEL ** -0.5)
    ada_b = nrm((DEPTH, N_MOD * D_MODEL), 0.02)
    norm_g = 1.0 + nrm((DEPTH, 3, D_MODEL), 0.05)
    ffn_w_in = nrm((DEPTH, 2, D_MODEL, 2 * D_FF), D_MODEL ** -0.5)
    ffn_w_out = nrm((DEPTH, 2, D_FF, D_MODEL), D_FF ** -0.5)
    rg_w_in = nrm((n_a, D_MODEL, 2 * D_RNN), D_MODEL ** -0.5)
    rg_conv_w = nrm((n_a, CONV_W, D_RNN), CONV_W ** -0.5)
    rg_conv_b = nrm((n_a, D_RNN), 0.02)
    rg_w_a = nrm((n_a, 2, RG_BLOCKS, RG_BLOCK, RG_BLOCK), RG_BLOCK ** -0.5)
    rg_b_a = nrm((n_a, 2, D_RNN), 0.02)
    rg_w_i = nrm((n_a, 2, RG_BLOCKS, RG_BLOCK, RG_BLOCK), RG_BLOCK ** -0.5)
    rg_b_i = nrm((n_a, 2, D_RNN), 0.02)
    a_init = jax.random.uniform(next(ks), (n_a, 2, D_RNN), f32, minval=0.9, maxval=0.999) ** (1.0 / RG_C)
    rg_lambda = jnp.log(a_init) - jnp.log1p(-a_init)
    rg_w_out = nrm((n_a, D_RNN, D_MODEL), D_RNN ** -0.5)
    gla_w_in = nrm((n_b, D_MODEL, GLA_IN), D_MODEL ** -0.5)
    gla_w_g2 = nrm((n_b, 2, GLA_RANK, GLA_QK), GLA_RANK ** -0.5)
    gla_b_g = nrm((n_b, 2, GLA_QK), 0.02)
    gla_norm = 1.0 + nrm((n_b, GLA_V), 0.05)
    gla_w_out = nrm((n_b, GLA_V, D_MODEL), GLA_V ** -0.5)
    final_norm = 1.0 + nrm((D_MODEL,), 0.05)
    return {"x_prompt": x_prompt, "x_sample": x_sample, "c": c, "state_rglru": state_rglru,
            "state_gla": state_gla, "c_ctx": c_ctx, "ada_w": ada_w, "ada_b": ada_b, "norm_g": norm_g,
            "ffn_w_in": ffn_w_in, "ffn_w_out": ffn_w_out, "rg_w_in": rg_w_in, "rg_conv_w": rg_conv_w,
            "rg_conv_b": rg_conv_b, "rg_w_a": rg_w_a, "rg_b_a": rg_b_a, "rg_w_i": rg_w_i, "rg_b_i": rg_b_i,
            "rg_lambda": rg_lambda, "rg_w_out": rg_w_out, "gla_w_in": gla_w_in, "gla_w_g2": gla_w_g2,
            "gla_b_g": gla_b_g, "gla_norm": gla_norm, "gla_w_out": gla_w_out, "final_norm": final_norm}


def reference(x_prompt, x_sample, c, state_rglru, state_gla, c_ctx, ada_w, ada_b, norm_g, ffn_w_in, ffn_w_out,
              rg_w_in, rg_conv_w, rg_conv_b, rg_w_a, rg_b_a, rg_w_i, rg_b_i, rg_lambda, rg_w_out,
              gla_w_in, gla_w_g2, gla_b_g, gla_norm, gla_w_out, final_norm):
    rows = x_sample.shape[1] // GRID_W
    n_prompt = x_prompt.shape[0]
    rg_states, gla_states = [], []
    xp, xs = x_prompt, x_sample
    for i in range(DEPTH):
        mod_p = ada_mod(c_ctx, ada_w[i], ada_b[i])
        mod_s = ada_mod(c, ada_w[i], ada_b[i])
        xp = half_ffn(xp, mod_p, norm_g[i], 0, ffn_w_in[i, 0], ffn_w_out[i, 0])
        xs = half_ffn(xs, mod_s, norm_g[i], 0, ffn_w_in[i, 0], ffn_w_out[i, 0])
        hp = modulated(xp, mod_p, norm_g[i], 1)
        hs = modulated(xs, mod_s, norm_g[i], 1)
        j = i // N_MIXERS
        if i % N_MIXERS == 0:
            rg = (rg_w_in[j], rg_conv_w[j], rg_conv_b[j], rg_w_a[j], rg_b_a[j], rg_w_i[j], rg_b_i[j],
                  rg_lambda[j], rg_w_out[j])
            zero = jnp.zeros((n_prompt, D_RNN), jnp.float32)
            yp, st = rglru_mixer(hp, *rg, zero, zero)
            ys, _ = rglru_mixer(hs, *rg, state_rglru[:, j, 0], state_rglru[:, j, 1])
            rg_states.append(st.astype(x_prompt.dtype))
        else:
            gl = (gla_w_in[j], gla_w_g2[j], gla_b_g[j], gla_norm[j], gla_w_out[j])
            zero = jnp.zeros((n_prompt, GLA_HEADS, GLA_DK, GLA_DV), jnp.float32)
            yp, st = gla_mixer(hp, *gl, zero, zero)
            ys_cm, _ = gla_mixer(to_col_major(hs, rows), *gl, state_gla[:, j, 0], state_gla[:, j, 1])
            ys = from_col_major(ys_cm, rows)
            gla_states.append(st.astype(x_prompt.dtype))
        xp = xp + mod_p[:, :, 5] * yp
        xs = xs + mod_s[:, :, 5] * ys
        xp = half_ffn(xp, mod_p, norm_g[i], 2, ffn_w_in[i, 1], ffn_w_out[i, 1])
        xs = half_ffn(xs, mod_s, norm_g[i], 2, ffn_w_in[i, 1], ffn_w_out[i, 1])
    y_prompt = rms_norm(xp, final_norm)
    y_sample = rms_norm(xs, final_norm)
    new_state_rglru = jnp.stack(rg_states, axis=1)
    new_state_gla = jnp.stack(gla_states, axis=1)
    return (y_prompt, y_sample, new_state_rglru, new_state_gla)
```

```cpp
#include <hip/hip_runtime.h>
#include <hip/hip_cooperative_groups.h>
#include <cstdio>
#include <cstdint>
namespace cg = cooperative_groups;


#ifndef DUP_MASK
#define DUP_MASK 0u
#endif
#define GAS __attribute__((address_space(1)))
#define LAS __attribute__((address_space(3)))
typedef unsigned short bf16;
typedef unsigned v4u __attribute__((ext_vector_type(4)));
typedef unsigned v2u __attribute__((ext_vector_type(2)));
typedef float f32x4 __attribute__((ext_vector_type(4)));
typedef float f32x2 __attribute__((ext_vector_type(2)));
typedef short bf16x8 __attribute__((ext_vector_type(8)));

constexpr int DM = 1024, TOK = 8192, NPROMPT = 4096, DFF = 2816, DRNN = 1280;
constexpr int GLA_N = 3104, GLA_NP = 3328, PROJ_LD = 3072;
constexpr float EPS = 1e-6f;
constexpr size_t OUT_RG = (size_t)TOK * DM, OUT_GLA = OUT_RG + 16 * 2 * 1280;

constexpr size_t MiB = 1u << 20;
constexpr size_t WS_MOD = MiB / 2;
constexpr size_t WS_WFI = 1 * MiB;
constexpr size_t WS_WFO = 45 * MiB;
constexpr size_t WS_WRI = 67 * MiB;
constexpr size_t WS_WRO = 72 * MiB;
constexpr size_t WS_WGI = 75 * MiB;
constexpr size_t WS_WGO = 82 * MiB;
constexpr size_t WS_WGT = 84 * MiB;
constexpr size_t WS_XN  = 86 * MiB;
constexpr size_t WS_P   = 102 * MiB;
constexpr size_t WS_HID = 166 * MiB;
constexpr size_t WS_MIX = 210 * MiB;
constexpr size_t WS_Z   = WS_MIX + 48 * MiB;
constexpr size_t WS_PG  = 230 * MiB;
constexpr size_t WS_SEG = 259 * MiB;
constexpr size_t WS_QF = 166 * MiB, WS_KF = 182 * MiB, WS_DEC = 198 * MiB, WS_PF = 199 * MiB;
constexpr size_t WS_VF = 260 * MiB;
constexpr size_t WS_END = 276 * MiB;

typedef __bf16 bf16x2_t __attribute__((ext_vector_type(2)));
__device__ __forceinline__ unsigned cvt_pk_bf16(float lo, float hi) { f32x2 v = {lo, hi}; bf16x2_t b = __builtin_convertvector(v, bf16x2_t); return __builtin_bit_cast(unsigned, b); }
__device__ __forceinline__ float bf2f(unsigned short b) { return __uint_as_float(((unsigned)b) << 16); }
__device__ __forceinline__ float bflo(unsigned u) { return __uint_as_float(u << 16); }
__device__ __forceinline__ float bfhi(unsigned u) { return __uint_as_float(u & 0xffff0000u); }
__device__ __forceinline__ float fast_sigmoid(float x) { return __builtin_amdgcn_rcpf(1.0f + __expf(-x)); }
__device__ __forceinline__ float silu_f(float x) { return x * fast_sigmoid(x); }
__device__ __forceinline__ float gelu_tanh_f(float x) { return x * fast_sigmoid(1.5957691216057308f * (x + 0.044715f * x * x * x)); }
__device__ __forceinline__ float dpp_add(float v, const int ctrl_sel) {
    int r;
    switch (ctrl_sel) {
        case 0:  r = __builtin_amdgcn_update_dpp(0, __builtin_bit_cast(int, v), 0xB1, 0xF, 0xF, true); break;
        case 1:  r = __builtin_amdgcn_update_dpp(0, __builtin_bit_cast(int, v), 0x4E, 0xF, 0xF, true); break;
        case 2:  r = __builtin_amdgcn_update_dpp(0, __builtin_bit_cast(int, v), 0x141, 0xF, 0xF, true); break;
        default: r = __builtin_amdgcn_update_dpp(0, __builtin_bit_cast(int, v), 0x140, 0xF, 0xF, true); break;
    }
    return v + __builtin_bit_cast(float, r);
}
__device__ __forceinline__ float wave_sum(float v) {
    v = dpp_add(v, 0); v = dpp_add(v, 1); v = dpp_add(v, 2); v = dpp_add(v, 3);
    const int iv = __builtin_bit_cast(int, v);
    const float r0 = __builtin_bit_cast(float, __builtin_amdgcn_readlane(iv, 0)), r1 = __builtin_bit_cast(float, __builtin_amdgcn_readlane(iv, 16));
    const float r2 = __builtin_bit_cast(float, __builtin_amdgcn_readlane(iv, 32)), r3 = __builtin_bit_cast(float, __builtin_amdgcn_readlane(iv, 48));
    return (r0 + r1) + (r2 + r3);
}
#define LDS_BAR() do { asm volatile("s_waitcnt lgkmcnt(0)" ::: "memory"); __builtin_amdgcn_s_barrier(); asm volatile("" ::: "memory"); } while (0)
namespace pg8 {
#define PG8_LAS __attribute__((address_space(3)))
typedef unsigned short bf16_t;
constexpr int BM = 256, BK = 64, HALF = 128, HTB = HALF * BK * 2, STAGE_BYTES = 8 * HTB, NXCD = 8, WGM = 8;

__host__ __device__ __forceinline__ int lds_byte(int r, int c) { const int st = (r >> 4) * 2 + (c >> 5), rr = r & 15, cc = c & 31, ob = rr * 64 + cc * 2; return st * 1024 + (ob ^ (((ob >> 9) & 1) << 5)); }
__host__ __device__ __forceinline__ void stage_rc(int b, int& R, int& C) { const int st = b / 1024, sb = b % 1024, swz = sb ^ (((sb >> 9) & 1) << 5); R = (st >> 1) * 16 + swz / 64; C = (st & 1) * 32 + (swz % 64) / 2; }
__host__ __device__ __forceinline__ int perm32(int rho) { const int n = rho >> 4, i = rho & 15; return 8 * (i >> 2) + 4 * n + (i & 3); }

struct Unit { int pm, pn, ks; };
struct Gemm { const bf16_t* A; const bf16_t* Bt; int K, lda, ldb, ksA, ksB; };

struct Order {
    int nM, nNv, nNr, nwg, G, c;
    __device__ void init(int M, int Nreal, int nsplit, int G_, int c_) { nM = M / BM; nNr = Nreal / BM; nNv = nNr * nsplit; nwg = nM * nNv; G = G_; c = c_; }
    __device__ bool next(int i, Unit& u) const {
        const long L = (long)i * G + c; if (L >= nwg) return false;
        int wgid = (int)L; { const int q = nwg / NXCD, r = nwg % NXCD, xcd = wgid % NXCD, off = wgid / NXCD; wgid = (xcd < r ? xcd * (q + 1) : r * (q + 1) + (xcd - r) * q) + off; }
        const int nig = WGM * nNv, gid = wgid / nig, fm = gid * WGM, gsz = (nM - fm) < WGM ? (nM - fm) : WGM;
        u.pm = fm + ((wgid % nig) % gsz); const int pv = (wgid % nig) / gsz; u.pn = pv % nNr; u.ks = pv / nNr; return true;
    }
};

template <class Epi>
__device__ __forceinline__ void gemm_phase(PG8_LAS unsigned char* lds, const Gemm g, const Order& S, const Epi& E) {
    const int tid = threadIdx.x, wid = __builtin_amdgcn_readfirstlane(tid >> 6), lane = tid & 63, wr = wid >> 2, wc = wid & 3, fr = lane & 15, fq = lane >> 4;
    const int K = g.K, nt = K / BK;
    unsigned voffA[2], voffB[2];
#pragma unroll
    for (int i = 0; i < 2; ++i) { int R, C; stage_rc(tid * 16 + i * 8192, R, C); const int Rb = Epi::PERM ? ((R & ~31) + perm32(R & 31)) : R;
        voffA[i] = (unsigned)(R * g.lda + C) * 2u; voffB[i] = (unsigned)(Rb * g.ldb + C) * 2u; }
    const size_t kstep = (size_t)(BK * 2);
    const size_t hstepA = (size_t)HALF * g.lda * 2, hstepB = (size_t)HALF * g.ldb * 2;
    const unsigned ldsw = (unsigned)wid * 1024u;
    const int aoff = lds_byte(wr * 64 + fr, fq * 8), boff = lds_byte(wc * 32 + fr, fq * 8);
#define PG8_SA(b, h) (((b) * 2 + (h)) * HTB)
#define PG8_SB(b, h) ((4 + (b) * 2 + (h)) * HTB)
#define PG8_STAGE(bufoff, gbase, voff) do { _Pragma("unroll") for (int _i = 0; _i < 2; ++_i) \
        __builtin_amdgcn_global_load_lds((const unsigned*)((const char*)(gbase) + (voff)[_i]), (PG8_LAS unsigned*)(lds + (bufoff) + ldsw + _i * 8192), 16, 0, 0); } while (0)
#define PG8_LDA(dst, b, h) do { _Pragma("unroll") for (int m = 0; m < 4; ++m) _Pragma("unroll") for (int k = 0; k < 2; ++k) dst[m][k] = *(const PG8_LAS bf16x8*)(lds + PG8_SA(b, h) + aoff + m * 2048 + k * 1024); } while (0)
#define PG8_LDB(dst, b, h) do { _Pragma("unroll") for (int n = 0; n < 2; ++n) _Pragma("unroll") for (int k = 0; k < 2; ++k) dst[n][k] = *(const PG8_LAS bf16x8*)(lds + PG8_SB(b, h) + boff + n * 2048 + k * 1024); } while (0)
#define PG8_MMA(ai, bj, At, Bt) do { __builtin_amdgcn_s_setprio(1); _Pragma("unroll") for (int m = 0; m < 4; ++m) _Pragma("unroll") for (int n = 0; n < 2; ++n) _Pragma("unroll") for (int k = 0; k < 2; ++k) \
        acc[ai][bj][m][n] = __builtin_amdgcn_mfma_f32_16x16x32_bf16(Bt[n][k], At[m][k], acc[ai][bj][m][n], 0, 0, 0); __builtin_amdgcn_s_setprio(0); } while (0)
#define PG8_WAIT_V(n) asm volatile("s_waitcnt vmcnt(" #n ")" ::: "memory")
#define PG8_WAIT_L(n) asm volatile("s_waitcnt lgkmcnt(" #n ")" ::: "memory")
#define PG8_BAR __builtin_amdgcn_s_barrier()
#define PG8_SCHED __builtin_amdgcn_sched_barrier(0)
#define PG8_UA(u) ((const char*)g.A + (size_t)(u).pm * 2 * hstepA + (size_t)(u).ks * g.ksA * 2)
#define PG8_UB(u) ((const char*)g.Bt + (size_t)(u).pn * 2 * hstepB + (size_t)(u).ks * g.ksB * 2)
    Unit cur, nxt; int ui = 0;
    if (!S.next(0, cur)) return;
    f32x4 acc[2][2][4][2];
#pragma unroll
    for (int a = 0; a < 2; ++a)
#pragma unroll
        for (int b = 0; b < 2; ++b)
#pragma unroll
            for (int m = 0; m < 4; ++m)
#pragma unroll
                for (int n = 0; n < 2; ++n) acc[a][b][m][n] = (f32x4){0.f, 0.f, 0.f, 0.f};
    bf16x8 At[4][2], B0[2][2], B1[2][2];
    const char* cA = PG8_UA(cur); const char* cB = PG8_UB(cur);
    PG8_STAGE(PG8_SB(0, 0), cB, voffB); PG8_STAGE(PG8_SB(0, 1), cB + hstepB, voffB); PG8_STAGE(PG8_SA(0, 0), cA, voffA); PG8_STAGE(PG8_SA(0, 1), cA + hstepA, voffA);
    if (wr == 1) PG8_BAR;
    PG8_WAIT_V(2); PG8_BAR;
    PG8_STAGE(PG8_SB(1, 0), cB + kstep, voffB); PG8_STAGE(PG8_SA(1, 0), cA + kstep, voffA); PG8_STAGE(PG8_SB(1, 1), cB + hstepB + kstep, voffB);
    PG8_WAIT_V(6); PG8_BAR;
    for (;;) {
        const bool has_next = S.next(ui + 1, nxt);
        const char* nA = has_next ? PG8_UA(nxt) : cA; const char* nB = has_next ? PG8_UB(nxt) : cB;
        for (int t = 0; t < nt; t += 2) {
            const bool last = (t == nt - 2);
            const char* a1 = cA + (size_t)(t + 1) * kstep;
            const char* a2 = last ? nA : cA + (size_t)(t + 2) * kstep; const char* b2 = last ? nB : cB + (size_t)(t + 2) * kstep;
            const char* a3 = a2 + kstep; const char* b3 = b2 + kstep;
            PG8_LDB(B0, 0, 0); PG8_LDB(B1, 0, 1); PG8_SCHED; PG8_LDA(At, 0, 0); PG8_STAGE(PG8_SA(1, 1), a1 + hstepA, voffA);
            PG8_WAIT_V(8); PG8_WAIT_L(0); PG8_BAR; PG8_MMA(0, 0, At, B0); PG8_MMA(0, 1, At, B1); PG8_BAR; PG8_SCHED;
            PG8_LDA(At, 0, 1); PG8_STAGE(PG8_SB(0, 0), b2, voffB); PG8_STAGE(PG8_SB(0, 1), b2 + hstepB, voffB); PG8_STAGE(PG8_SA(0, 0), a2, voffA);
            PG8_WAIT_V(8); PG8_WAIT_L(0); PG8_BAR; PG8_MMA(1, 0, At, B0); PG8_MMA(1, 1, At, B1); PG8_BAR; PG8_SCHED;
            PG8_LDB(B0, 1, 0); PG8_LDB(B1, 1, 1); PG8_SCHED; PG8_LDA(At, 1, 0); PG8_STAGE(PG8_SA(0, 1), a2 + hstepA, voffA);
            PG8_WAIT_V(8); PG8_WAIT_L(0); PG8_BAR; PG8_MMA(0, 0, At, B0); PG8_MMA(0, 1, At, B1); PG8_BAR; PG8_SCHED;
            PG8_LDA(At, 1, 1); PG8_STAGE(PG8_SB(1, 0), b3, voffB); PG8_STAGE(PG8_SB(1, 1), b3 + hstepB, voffB); PG8_STAGE(PG8_SA(1, 0), a3, voffA);
            PG8_WAIT_V(8); PG8_WAIT_L(0); PG8_BAR; PG8_MMA(1, 0, At, B0); PG8_MMA(1, 1, At, B1); PG8_BAR; PG8_SCHED;
        }
        if (wr == 0) PG8_BAR;
        E(acc, cur, wr, wc, fr, fq);
        if (!has_next) break;
#pragma unroll
        for (int a = 0; a < 2; ++a)
#pragma unroll
            for (int b = 0; b < 2; ++b)
#pragma unroll
                for (int m = 0; m < 4; ++m)
#pragma unroll
                    for (int n = 0; n < 2; ++n) acc[a][b][m][n] = (f32x4){0.f, 0.f, 0.f, 0.f};
        cur = nxt; cA = nA; cB = nB; ++ui;
        if (wr == 1) PG8_BAR;
    }
    PG8_WAIT_V(0);
    PG8_BAR;
#undef PG8_SA
#undef PG8_SB
#undef PG8_STAGE
#undef PG8_LDA
#undef PG8_LDB
#undef PG8_MMA
#undef PG8_WAIT_V
#undef PG8_WAIT_L
#undef PG8_BAR
#undef PG8_SCHED
#undef PG8_UA
#undef PG8_UB
}

struct EpiSwiglu {
    static constexpr bool PERM = true;
    bf16_t* H;
    __device__ __forceinline__ void operator()(const f32x4 (&acc)[2][2][4][2], const Unit& u, int wr, int wc, int fr, int fq) const {
        const int row0 = u.pm * BM + wr * 64 + fr, colh = u.pn * 128 + wc * 32 + 8 * fq;
#pragma unroll
        for (int ai = 0; ai < 2; ++ai)
#pragma unroll
            for (int m = 0; m < 4; ++m) {
                const f32x4 g0 = acc[ai][0][m][0], g1 = acc[ai][0][m][1], u0 = acc[ai][1][m][0], u1 = acc[ai][1][m][1];
                v4u w;
                w.x = cvt_pk_bf16(silu_f(g0[0]) * u0[0], silu_f(g0[1]) * u0[1]); w.y = cvt_pk_bf16(silu_f(g0[2]) * u0[2], silu_f(g0[3]) * u0[3]);
                w.z = cvt_pk_bf16(silu_f(g1[0]) * u1[0], silu_f(g1[1]) * u1[1]); w.w = cvt_pk_bf16(silu_f(g1[2]) * u1[2], silu_f(g1[3]) * u1[3]);
                *(v4u*)(H + (size_t)(row0 + ai * HALF + m * 16) * DFF + colh) = w;
            }
    }
};
struct EpiPart {
    static constexpr bool PERM = true;
    bf16_t* P;
    __device__ __forceinline__ void operator()(const f32x4 (&acc)[2][2][4][2], const Unit& u, int wr, int wc, int fr, int fq) const {
        bf16_t* base = P + (size_t)u.ks * TOK * DM + (size_t)(u.pm * BM + wr * 64 + fr) * DM + u.pn * BM + wc * 32 + 8 * fq;
#pragma unroll
        for (int ai = 0; ai < 2; ++ai)
#pragma unroll
            for (int m = 0; m < 4; ++m)
#pragma unroll
                for (int bj = 0; bj < 2; ++bj) { const f32x4 a = acc[ai][bj][m][0], b = acc[ai][bj][m][1];
                    *(v4u*)(base + (size_t)(ai * HALF + m * 16) * DM + bj * HALF) = (v4u){cvt_pk_bf16(a[0], a[1]), cvt_pk_bf16(a[2], a[3]), cvt_pk_bf16(b[0], b[1]), cvt_pk_bf16(b[2], b[3])}; }
    }
};
struct EpiRgIn {
    static constexpr bool PERM = true;
    bf16_t* GG; bf16_t* XBR;
    __device__ __forceinline__ void operator()(const f32x4 (&acc)[2][2][4][2], const Unit& u, int wr, int wc, int fr, int fq) const {
        const int row0 = u.pm * BM + wr * 64 + fr;
        if (u.pn < 5) {
            const int col0 = u.pn * BM + wc * 32 + 8 * fq;
#pragma unroll
            for (int ai = 0; ai < 2; ++ai)
#pragma unroll
                for (int m = 0; m < 4; ++m)
#pragma unroll
                    for (int bj = 0; bj < 2; ++bj) {
                        const f32x4 a = acc[ai][bj][m][0], b = acc[ai][bj][m][1]; v4u w;
                        w.x = cvt_pk_bf16(gelu_tanh_f(a[0]), gelu_tanh_f(a[1])); w.y = cvt_pk_bf16(gelu_tanh_f(a[2]), gelu_tanh_f(a[3]));
                        w.z = cvt_pk_bf16(gelu_tanh_f(b[0]), gelu_tanh_f(b[1])); w.w = cvt_pk_bf16(gelu_tanh_f(b[2]), gelu_tanh_f(b[3]));
                        *(v4u*)(GG + (size_t)(row0 + ai * HALF + m * 16) * DRNN + col0 + bj * HALF) = w;
                    }
        } else {
            const int col0 = (u.pn - 5) * BM + wc * 32 + 8 * fq;
#pragma unroll
            for (int ai = 0; ai < 2; ++ai)
#pragma unroll
                for (int m = 0; m < 4; ++m)
#pragma unroll
                    for (int bj = 0; bj < 2; ++bj) {
                        const f32x4 a = acc[ai][bj][m][0], b = acc[ai][bj][m][1];
                        *(v4u*)(XBR + (size_t)(row0 + ai * HALF + m * 16) * DRNN + col0 + bj * HALF) = (v4u){cvt_pk_bf16(a[0], a[1]), cvt_pk_bf16(a[2], a[3]), cvt_pk_bf16(b[0], b[1]), cvt_pk_bf16(b[2], b[3])};
                    }
        }
    }
};
struct EpiGlaIn {
    static constexpr bool PERM = true;
    bf16_t* PROJ; float* Z;
    __device__ __forceinline__ void operator()(const f32x4 (&acc)[2][2][4][2], const Unit& u, int wr, int wc, int fr, int fq) const {
        const int row0 = u.pm * BM + wr * 64 + fr;
        if (u.pn < 12) {
            const int col0 = u.pn * BM + wc * 32 + 8 * fq;
            const float sc = (u.pn < 2) ? 0.08838834764831845f : 1.0f; const bool act = (u.pn >= 8);
#pragma unroll
            for (int ai = 0; ai < 2; ++ai)
#pragma unroll
                for (int m = 0; m < 4; ++m)
#pragma unroll
                    for (int bj = 0; bj < 2; ++bj) {
                        f32x4 a = acc[ai][bj][m][0] * sc, b = acc[ai][bj][m][1] * sc;
                        if (act) { a = (f32x4){silu_f(a[0]), silu_f(a[1]), silu_f(a[2]), silu_f(a[3])}; b = (f32x4){silu_f(b[0]), silu_f(b[1]), silu_f(b[2]), silu_f(b[3])}; }
                        v4u w; w.x = cvt_pk_bf16(a[0], a[1]); w.y = cvt_pk_bf16(a[2], a[3]); w.z = cvt_pk_bf16(b[0], b[1]); w.w = cvt_pk_bf16(b[2], b[3]);
                        *(v4u*)(PROJ + (size_t)(row0 + ai * HALF + m * 16) * PROJ_LD + col0 + bj * HALF) = w;
                    }
        } else if (wc == 0) {
#pragma unroll
            for (int ai = 0; ai < 2; ++ai)
#pragma unroll
                for (int m = 0; m < 4; ++m) {
                    float* p = Z + (size_t)(row0 + ai * HALF + m * 16) * 32 + 8 * fq;
                    *(f32x4*)p = acc[ai][0][m][0]; *(f32x4*)(p + 4) = acc[ai][0][m][1];
                }
        }
    }
};
}

struct Args { const float* in[26]; float* out; unsigned char* ws; int ph_lo, ph_hi; };
enum { I_XP = 0, I_XS, I_C, I_SRG, I_SGLA, I_CCTX, I_ADAW, I_ADAB, I_NORMG, I_FWI, I_FWO, I_RWI, I_RCW, I_RCB, I_RWA, I_RBA, I_RWIG, I_RBI, I_RLAM, I_RWO,
       I_GWI, I_GW2, I_GBG, I_GNORM, I_GWO, I_FNORM };

__device__ __forceinline__ void transpose_item(const float* W, int N, int k0, int n0, bf16* dst, int ldk, LAS float* scr, int lane) {
    float tv[32];
#pragma unroll
    for (int i = 0; i < 32; ++i) tv[i] = __builtin_nontemporal_load(&W[(size_t)(k0 + 2 * i + (lane >> 5)) * N + n0 + (lane & 31)]);
#pragma unroll
    for (int i = 0; i < 32; ++i) scr[(2 * i + (lane >> 5)) * 33 + (lane & 31)] = tv[i];
    asm volatile("s_waitcnt lgkmcnt(0)" ::: "memory");
    const int c = lane & 7;
#pragma unroll
    for (int j = 0; j < 4; ++j) { const int n = (lane >> 3) + 8 * j; const LAS float* s = scr + (8 * c) * 33 + n;
        v4u o; o.x = cvt_pk_bf16(s[0 * 33], s[1 * 33]); o.y = cvt_pk_bf16(s[2 * 33], s[3 * 33]); o.z = cvt_pk_bf16(s[4 * 33], s[5 * 33]); o.w = cvt_pk_bf16(s[6 * 33], s[7 * 33]);
        *(v4u*)(dst + (size_t)n * ldk + k0 + 8 * c) = o; }
    asm volatile("s_waitcnt lgkmcnt(0)" ::: "memory");
}

__device__ __forceinline__ void ada_items(const Args& a, LAS unsigned char* lds, const int first, const int stride, const int limit) {
    const int tid = threadIdx.x, lane = tid & 63, wave = tid >> 6;
    if (first >= limit) return;
    LAS float* sv = (LAS float*)lds;
    LAS float* red = (LAS float*)(lds + 12288);
    for (int i = tid; i < 3 * 1024; i += 512) { const int g = i >> 10, k = i & 1023; const float v = (g == 0) ? a.in[I_CCTX][k] : a.in[I_C][(g - 1) * 1024 + k]; sv[i] = silu_f(v); }
    __syncthreads();
    float* mod = (float*)(a.ws + WS_MOD);
    for (int it = first; it < limit; it += stride) {
        const int l = it / 144, n0 = (it % 144) * 64;
        const float* W = a.in[I_ADAW] + (size_t)l * 1024 * 9216 + n0 + lane;
        float a0 = 0.f, a1 = 0.f, a2 = 0.f;
        const int kb = wave * 128;
#pragma unroll 16
        for (int k = 0; k < 128; ++k) { const float wv = __builtin_nontemporal_load(&W[(size_t)(kb + k) * 9216]); a0 += sv[kb + k] * wv; a1 += sv[1024 + kb + k] * wv; a2 += sv[2048 + kb + k] * wv; }
        red[(wave * 3 + 0) * 64 + lane] = a0; red[(wave * 3 + 1) * 64 + lane] = a1; red[(wave * 3 + 2) * 64 + lane] = a2;
        __syncthreads();
        if (tid < 192) { const int g = tid >> 6, c = tid & 63; float sm = a.in[I_ADAB][l * 9216 + n0 + c];
#pragma unroll
            for (int w = 0; w < 8; ++w) sm += red[(w * 3 + g) * 64 + c];
            mod[(size_t)(l * 3 + g) * 9216 + n0 + c] = sm; }
        __syncthreads();
    }
}

__device__ __forceinline__ void convert_weights(const Args& a, LAS unsigned char* lds, const int group, const int first, const int step, const int end, const int gw, const int NGW) {
    const int lane = threadIdx.x & 63, wave = threadIdx.x >> 6;
    unsigned char* ws = a.ws;
    LAS float* scr = (LAS float*)(lds + wave * 16384);
    constexpr int I_FI = 16 * 176, I_FO = 44 * 32, I_RI = 16 * 80, I_RO = 20 * 32, I_GI = 16 * 97, I_GO = 16 * 32, I_GT = 8;
    const int mi0 = (group == 0) ? 0 : group + 1, nmi = (group == 0) ? 2 : 1;
    const int n_ri = (group == 0) ? I_RI : 0, n_ro = (group == 0) ? I_RO : 0, n_gt = (group == 0) ? 40 * I_GT : 0;
    const int n_gi = (group == 1) ? I_GI : 0, n_go = (group == 1) ? I_GO : 0;
    const int nitems = nmi * (I_FI + I_FO) + n_ri + n_ro + n_gi + n_go + n_gt;
    const int stop = end < nitems ? end : nitems;
    for (int it = first; it < stop; it += step) {
        int r = it;
        if (r < nmi * I_FI) { const int mi = mi0 + r / I_FI; r %= I_FI; const int kb = r / 176, n0 = (r % 176) * 32;
            const int drow = (n0 < DFF) ? (n0 / 128) * 256 + (n0 % 128) : ((n0 - DFF) / 128) * 256 + 128 + ((n0 - DFF) % 128);
            transpose_item(a.in[I_FWI] + (size_t)mi * 1024 * 5632, 5632, kb * 64, n0, (bf16*)(ws + WS_WFI) + ((size_t)mi * 5632 + drow) * 1024, 1024, scr, lane); continue; }
        r -= nmi * I_FI;
        if (r < nmi * I_FO) { const int mi = mi0 + r / I_FO; r %= I_FO; const int kb = r / 32, n0 = (r % 32) * 32;
            transpose_item(a.in[I_FWO] + (size_t)mi * 2816 * 1024, 1024, kb * 64, n0, (bf16*)(ws + WS_WFO) + ((size_t)mi * 1024 + n0) * 2816, 2816, scr, lane); continue; }
        r -= nmi * I_FO;
        if (r < n_ri) { const int kb = r / 80, n0 = (r % 80) * 32;
            transpose_item(a.in[I_RWI], 2560, kb * 64, n0, (bf16*)(ws + WS_WRI) + (size_t)n0 * 1024, 1024, scr, lane); continue; }
        r -= n_ri;
        if (r < n_ro) { const int kb = r / 32, n0 = (r % 32) * 32;
            transpose_item(a.in[I_RWO], 1024, kb * 64, n0, (bf16*)(ws + WS_WRO) + (size_t)n0 * 1280, 1280, scr, lane); continue; }
        r -= n_ro;
        if (r < n_gi) { const int kb = r / 97, n0 = (r % 97) * 32;
            transpose_item(a.in[I_GWI], GLA_N, kb * 64, n0, (bf16*)(ws + WS_WGI) + (size_t)n0 * 1024, 1024, scr, lane); continue; }
        r -= n_gi;
        if (r < n_go) { const int kb = r / 32, n0 = (r % 32) * 32;
            transpose_item(a.in[I_GWO], 1024, kb * 64, n0, (bf16*)(ws + WS_WGO) + (size_t)n0 * 1024, 1024, scr, lane); continue; }
        r -= n_go;
        { const int mi = r / I_GT; r %= I_GT; const int kb = r / 4, n0 = (r % 4) * 32;
          const int which = mi / 20, dn = mi % 20;
          const float* src = (which ? a.in[I_RWIG] : a.in[I_RWA]) + (size_t)dn * 128 * 128;
          transpose_item(src, 128, kb * 64, n0, (bf16*)(ws + WS_WGT) + ((size_t)dn * 256 + which * 128 + n0) * 128, 128, scr, lane); }
    }
    if (group == 1) {
        v4u* z = (v4u*)((bf16*)(ws + WS_WGI) + (size_t)GLA_N * 1024);
        const int nz = (GLA_NP - GLA_N) * 1024 * 2 / 16;
        for (int i = gw * 64 + lane; i < nz; i += NGW * 64) z[i] = (v4u){0u, 0u, 0u, 0u};
    }
}

__device__ __forceinline__ void phase_prep(const Args& a, LAS unsigned char* lds) {
    const int tid = threadIdx.x, lane = tid & 63, wave = tid >> 6;
    unsigned char* ws = a.ws;
    ada_items(a, lds, (int)blockIdx.x, (int)gridDim.x, (gridDim.x == 256) ? 144 : 288);
    __syncthreads();
    {
        const int gw = blockIdx.x * 8 + wave, NGW = gridDim.x * 8;
        if (gridDim.x == 256) {
            constexpr int N0 = 2 * (16 * 176) + 2 * (44 * 32) + 16 * 80 + 20 * 32 + 40 * 8, WTOT = 144 * 73 + 112 * 100;
            const int b = blockIdx.x;
            const int cw0 = (b < 144) ? 73 * b : 144 * 73 + 100 * (b - 144), cw1 = (b + 1 <= 144) ? 73 * (b + 1) : 144 * 73 + 100 * (b + 1 - 144);
            const int st = (int)(((long)N0 * cw0) / WTOT), en = (int)(((long)N0 * cw1) / WTOT);
            convert_weights(a, lds, 0, st + wave, 8, en, gw, NGW);
        } else {
            convert_weights(a, lds, 0, gw, NGW, 0x7fffffff, gw, NGW); convert_weights(a, lds, 1, gw, NGW, 0x7fffffff, gw, NGW); convert_weights(a, lds, 2, gw, NGW, 0x7fffffff, gw, NGW);
        }
    }
}

__device__ __forceinline__ void phase_combine(const Args& a, int first, int fin, int lg, int jg, float coef, int ln, int jn) {
    const int tid = threadIdx.x, lane = tid & 63, wave = tid >> 6;
    const int gw = blockIdx.x * 8 + wave, NGW = gridDim.x * 8;
    float* X = a.out; const float* mod = (const float*)(a.ws + WS_MOD); const bf16* P = (const bf16*)(a.ws + WS_P); bf16* XN = (bf16*)(a.ws + WS_XN);
    const bool aff = (gridDim.x == 256);
    const int affm0 = 2048 * ((blockIdx.x & 7) >> 1) + 32 * ((blockIdx.x & 1) * 32 + (blockIdx.x >> 3)) + 4 * wave;
    for (int m0 = aff ? affm0 : gw * 4; m0 < TOK; m0 += aff ? TOK : NGW * 4) {
        const int g = (m0 < NPROMPT) ? 0 : 1 + ((m0 - NPROMPT) >> 11);
        f32x4 cg[2][2], gs[2][2], sh[2][2];
#pragma unroll
        for (int c = 0; c < 2; ++c)
#pragma unroll
            for (int h = 0; h < 2; ++h) { const int i4 = 128 * c + 2 * lane + h;
                cg[c][h] = first ? (f32x4){0.f, 0.f, 0.f, 0.f} : coef * ((const f32x4*)(mod + (size_t)((lg * 3 + g) * 9 + 3 * jg + 2) * DM))[i4];
                if (fin) { gs[c][h] = ((const f32x4*)a.in[I_FNORM])[i4]; sh[c][h] = (f32x4){0.f, 0.f, 0.f, 0.f}; }
                else { gs[c][h] = ((const f32x4*)(a.in[I_NORMG] + (size_t)(ln * 3 + jn) * DM))[i4] * (1.0f + ((const f32x4*)(mod + (size_t)((ln * 3 + g) * 9 + 3 * jn + 1) * DM))[i4]);
                       sh[c][h] = ((const f32x4*)(mod + (size_t)((ln * 3 + g) * 9 + 3 * jn) * DM))[i4]; } }
#pragma unroll 2
        for (int r = 0; r < 4; ++r) {
            const int m = m0 + r;
            const float* xs = first ? ((m < NPROMPT) ? a.in[I_XP] + (size_t)m * DM : a.in[I_XS] + (size_t)(m - NPROMPT) * DM) : X + (size_t)m * DM;
            f32x4 v[2][2];
#pragma unroll
            for (int c = 0; c < 2; ++c)
#pragma unroll
                for (int h = 0; h < 2; ++h) { const f32x4* px = &((const f32x4*)xs)[128 * c + 2 * lane + h]; v[c][h] = first ? __builtin_nontemporal_load(px) : *px; }
            if (!first) {
                const v4u* p0 = (const v4u*)(P + (size_t)m * DM); const v4u* p1 = (const v4u*)(P + (size_t)TOK * DM + (size_t)m * DM);
#pragma unroll
                for (int c = 0; c < 2; ++c) { const v4u a0 = p0[64 * c + lane], a1 = p1[64 * c + lane];
                    v[c][0] += cg[c][0] * (f32x4){bflo(a0.x) + bflo(a1.x), bfhi(a0.x) + bfhi(a1.x), bflo(a0.y) + bflo(a1.y), bfhi(a0.y) + bfhi(a1.y)};
                    v[c][1] += cg[c][1] * (f32x4){bflo(a0.z) + bflo(a1.z), bfhi(a0.z) + bfhi(a1.z), bflo(a0.w) + bflo(a1.w), bfhi(a0.w) + bfhi(a1.w)}; }
            }
            float ss = 0.f;
#pragma unroll
            for (int c = 0; c < 2; ++c)
#pragma unroll
                for (int h = 0; h < 2; ++h) ss += (v[c][h][0] * v[c][h][0] + v[c][h][1] * v[c][h][1]) + (v[c][h][2] * v[c][h][2] + v[c][h][3] * v[c][h][3]);
            const float rstd = 1.0f / sqrtf(wave_sum(ss) * (1.0f / DM) + EPS);
            if (fin) {
#pragma unroll
                for (int c = 0; c < 2; ++c)
#pragma unroll
                    for (int h = 0; h < 2; ++h) ((f32x4*)(X + (size_t)m * DM))[128 * c + 2 * lane + h] = v[c][h] * rstd * gs[c][h];
            } else {
#pragma unroll
                for (int c = 0; c < 2; ++c) {
                    ((f32x4*)(X + (size_t)m * DM))[128 * c + 2 * lane] = v[c][0]; ((f32x4*)(X + (size_t)m * DM))[128 * c + 2 * lane + 1] = v[c][1];
                    const f32x4 y0 = (v[c][0] * rstd) * gs[c][0] + sh[c][0], y1 = (v[c][1] * rstd) * gs[c][1] + sh[c][1];
                    ((v4u*)(XN + (size_t)m * DM))[64 * c + lane] = (v4u){cvt_pk_bf16(y0[0], y0[1]), cvt_pk_bf16(y0[2], y0[3]), cvt_pk_bf16(y1[0], y1[1]), cvt_pk_bf16(y1[2], y1[3])};
                }
            }
        }
    }
}

__device__ __forceinline__ void phase_rg(const Args& a, LAS unsigned char* lds) {
    const int tid = threadIdx.x, lane = tid & 63, w = __builtin_amdgcn_readfirstlane(tid >> 6), l15 = lane & 15, lq = lane >> 4;
    unsigned char* ws = a.ws;
    const bf16* XBR = (const bf16*)(ws + WS_P);
    const bf16* GG = (const bf16*)(ws + WS_MIX);
    bf16* Y2 = (bf16*)(ws + WS_HID);
    bf16* PG = (bf16*)(ws + WS_PG);
    const bf16* WG = (const bf16*)(ws + WS_WGT);
    f32x2* SEG = (f32x2*)(ws + WS_SEG);
    LAS float* XCF = (LAS float*)lds;
    LAS unsigned short* XA = (LAS unsigned short*)(lds + 32768);
    LAS f32x2* AU = (LAS f32x2*)(lds + 50176);
    const int cc = tid & 127, tg = w >> 1;
    const int nitems = 320 + 640;
    const bool deal = (gridDim.x == 256);
    for (int kk = 0;; ++kk) {
        int it;
        if (deal) { const int b = blockIdx.x; if (kk > 3) break;
            if (kk == 0) it = b; else if (kk == 1) it = (b < 64) ? 256 + b : 320 + (b - 64); else if (kk == 2) it = 320 + 192 + b; else { if (b < 64) break; it = 320 + 448 + (b - 64); } }
        else { it = blockIdx.x + kk * gridDim.x; if (it >= nitems) break; }
        int s, r, pseg = 0, sb = 0;
        if (it < 320) { s = it / 20; r = it % 20; }
        else { const int q = it - 320; sb = q / 320; const int q2 = q % 320; pseg = q2 / 20; r = q2 % 20; s = 16 + sb; }
        const bool fix = (s >= 16 && pseg >= 1);
        const int n = r >> 1, d = r & 1;
        const int T = (s < 16) ? 256 : 2048, mb = (s < 16) ? s * 256 : NPROMPT + (s - 16) * 2048;
        const int ti0 = (s < 16) ? 0 : 2 * pseg, ti1 = (s < 16) ? 4 : 2 * pseg + 2;
        bf16x8 bfr[2][4];
        { const bf16* wg = WG + (size_t)((d * 10 + n) * 256) * 128;
#pragma unroll
          for (int f = 0; f < 2; ++f)
#pragma unroll
              for (int ks = 0; ks < 4; ++ks) bfr[f][ks] = *(const bf16x8*)(wg + (size_t)(f * 128 + 16 * w + l15) * 128 + 32 * ks + 8 * lq); }
        const int ch = 16 * w + l15, C = n * 128 + ch;
        const float ba = a.in[I_RBA][d * DRNN + C], bi = a.in[I_RBI][d * DRNN + C];
        float sp8; { const float nl = -a.in[I_RLAM][d * DRNN + C]; sp8 = 8.0f * (fmaxf(nl, 0.f) + log1pf(__expf(-fabsf(nl)))); }
        const int Cc = n * 128 + cc;
        const float w0 = a.in[I_RCW][Cc], w1 = a.in[I_RCW][DRNN + Cc], w2 = a.in[I_RCW][2 * DRNN + Cc], w3 = a.in[I_RCW][3 * DRNN + Cc], cb = a.in[I_RCB][Cc];
        float h = 0.f, pprod = 1.f;
        if (tid < 128 && s >= 16 && pseg == 0) h = a.in[I_SRG][((s - 16) * 2 + d) * DRNN + n * 128 + tid];
        unsigned xr[19]; unsigned ggp[8]; unsigned xm = 0u;
#pragma unroll
        for (int p = 0; p < 8; ++p) ggp[p] = 0u;
#define RG_LOAD(ti_) do { const int t0_ = d ? T - 64 * ((ti_) + 1) : 64 * (ti_); const int ts_ = t0_ + 16 * tg - 1; \
        const bf16* xp_ = XBR + (long)(mb + ts_) * DRNN + Cc; xm = 0u; \
        _Pragma("unroll") for (int i = 0; i < 19; ++i) { xr[i] = (unsigned)xp_[i * DRNN]; xm |= ((unsigned)(ts_ + i) < (unsigned)T) ? (1u << i) : 0u; } \
        const bf16* gp_ = GG + (size_t)(mb + t0_ + w) * DRNN + n * 128 + lane * 2; \
        _Pragma("unroll") for (int p = 0; p < 8; ++p) ggp[p] = *(const unsigned*)(gp_ + (size_t)(8 * p) * DRNN); } while (0)
        RG_LOAD(ti0);
        for (int ti = ti0; ti < ti1; ++ti) {
            const int t0 = d ? T - 64 * (ti + 1) : 64 * ti;
            float xv[19];
#pragma unroll
            for (int i = 0; i < 19; ++i) xv[i] = ((xm >> i) & 1u) ? __uint_as_float(xr[i] << 16) : 0.f;
#pragma unroll
            for (int i = 0; i < 16; ++i) { const float xc = cb + w0 * xv[i] + w1 * xv[i + 1] + w2 * xv[i + 2] + w3 * xv[i + 3];
                const int tl = 16 * tg + i; XCF[tl * 128 + cc] = xc; XA[tl * 136 + cc] = (unsigned short)(cvt_pk_bf16(xc, 0.f) & 0xffffu); }
            unsigned ggc[8];
#pragma unroll
            for (int p = 0; p < 8; ++p) ggc[p] = ggp[p];
            LDS_BAR();
            if (ti + 1 < ti1) RG_LOAD(ti + 1);
            f32x4 accA[4], accI[4]; float xcv[16];
#pragma unroll
            for (int mf = 0; mf < 4; ++mf) { accA[mf] = (f32x4){0.f, 0.f, 0.f, 0.f}; accI[mf] = (f32x4){0.f, 0.f, 0.f, 0.f}; }
#pragma unroll
            for (int e = 0; e < 16; ++e) xcv[e] = XCF[(16 * (e >> 2) + 4 * lq + (e & 3)) * 128 + ch];
#pragma unroll
            for (int ks = 0; ks < 4; ++ks)
#pragma unroll
                for (int mf = 0; mf < 4; ++mf) { const bf16x8 af = *(const LAS bf16x8*)(XA + (16 * mf + l15) * 136 + 32 * ks + 8 * lq);
                    accA[mf] = __builtin_amdgcn_mfma_f32_16x16x32_bf16(af, bfr[0][ks], accA[mf], 0, 0, 0);
                    accI[mf] = __builtin_amdgcn_mfma_f32_16x16x32_bf16(af, bfr[1][ks], accI[mf], 0, 0, 0); }
#pragma unroll
            for (int mf = 0; mf < 4; ++mf)
#pragma unroll
                for (int rg = 0; rg < 4; ++rg) { const int tl = 16 * mf + 4 * lq + rg;
                    const float rr = fast_sigmoid(accA[mf][rg] + ba), gi = fast_sigmoid(accI[mf][rg] + bi);
                    const float la = -sp8 * rr; const float av = __expf(la); const float uu = __builtin_amdgcn_sqrtf(fmaxf(1.0f - av * av, 0.f)) * gi * xcv[mf * 4 + rg];
                    AU[tl * 128 + ch] = (f32x2){av, uu}; }
            LDS_BAR();
            if (tid < 128) {
#pragma unroll 1
                for (int i0 = 0; i0 < 64; i0 += 8) {
                    f32x2 au[8];
#pragma unroll
                    for (int k = 0; k < 8; ++k) { const int tl = d ? 63 - (i0 + k) : i0 + k; au[k] = AU[tl * 128 + tid]; }
#pragma unroll
                    for (int k = 0; k < 8; ++k) { h = au[k].x * h + au[k].y; pprod *= au[k].x; au[k] = (f32x2){h, pprod}; }
#pragma unroll
                    for (int k = 0; k < 8; ++k) { const int tl = d ? 63 - (i0 + k) : i0 + k; AU[tl * 128 + tid] = au[k]; }
                }
            }
            LDS_BAR();
            f32x4 hp[8];
#pragma unroll
            for (int p = 0; p < 8; ++p) hp[p] = *(const LAS f32x4*)(AU + (8 * p + w) * 128 + lane * 2);
#pragma unroll
            for (int p = 0; p < 8; ++p) { const int tl = 8 * p + w, cp = lane * 2; const float g0 = bflo(ggc[p]), g1 = bfhi(ggc[p]);
                *(unsigned*)(Y2 + (size_t)(mb + t0 + tl) * (2 * DRNN) + d * DRNN + n * 128 + cp) = cvt_pk_bf16(hp[p][0] * g0, hp[p][2] * g1);
                if (fix) *(unsigned*)(PG + (size_t)(mb - NPROMPT + t0 + tl) * (2 * DRNN) + d * DRNN + n * 128 + cp) = cvt_pk_bf16(hp[p][1] * g0, hp[p][3] * g1); }
            LDS_BAR();
        }
#undef RG_LOAD
        if (tid < 128) {
            if (s < 16) a.out[OUT_RG + (size_t)(s * 2 + d) * DRNN + n * 128 + tid] = h;
            else SEG[(size_t)((sb * 16 + pseg) * 2 + d) * DRNN + n * 128 + tid] = (f32x2){pprod, h};
        }
    }
}

__device__ __forceinline__ void phase_rg_fix(const Args& a) {
    const int tid = threadIdx.x;
    unsigned char* ws = a.ws;
    bf16* Y2 = (bf16*)(ws + WS_HID); const bf16* PG = (const bf16*)(ws + WS_PG); const f32x2* SEG = (const f32x2*)(ws + WS_SEG);
    const int cp = (tid & 63) * 2, r8 = tid >> 6;
    for (int it = blockIdx.x; it < 640; it += gridDim.x) {
        const int n = it % 10, q = it / 10;
        const bool smp = q >= 32;
        const int sb = smp ? ((q - 32) >> 4) : 0, ts = smp ? ((q - 32) & 15) : 0;
        const int mb = smp ? NPROMPT + sb * 2048 + ts * 128 : q * 128;
        const int psf = smp ? ts : 0, psb = smp ? 15 - ts : 0;
        float hf0 = 0.f, hf1 = 0.f, hb0 = 0.f, hb1 = 0.f;
        if (smp) {
            f32x4 sf[15], sbk[15];
#pragma unroll
            for (int j = 0; j < 15; ++j) {
                sf[j]  = (j < psf) ? *(const f32x4*)(SEG + (size_t)((sb * 16 + j) * 2 + 0) * DRNN + n * 128 + cp) : (f32x4){1.f, 0.f, 1.f, 0.f};
                sbk[j] = (j < psb) ? *(const f32x4*)(SEG + (size_t)((sb * 16 + j) * 2 + 1) * DRNN + n * 128 + cp) : (f32x4){1.f, 0.f, 1.f, 0.f}; }
            hf0 = sf[0][1]; hf1 = sf[0][3]; hb0 = sbk[0][1]; hb1 = sbk[0][3];
#pragma unroll
            for (int j = 1; j < 15; ++j) { hf0 = sf[j][0] * hf0 + sf[j][1]; hf1 = sf[j][2] * hf1 + sf[j][3]; hb0 = sbk[j][0] * hb0 + sbk[j][1]; hb1 = sbk[j][2] * hb1 + sbk[j][3]; }
            if (psf == 0) { hf0 = 0.f; hf1 = 0.f; }
            if (psb == 0) { hb0 = 0.f; hb1 = 0.f; }
        }
        unsigned yf[16], yb[16], pf[16], pb[16];
#pragma unroll
        for (int i = 0; i < 16; ++i) { const size_t row = (size_t)(mb + 8 * i + r8);
            yf[i] = *(const unsigned*)(Y2 + row * (2 * DRNN) + n * 128 + cp); yb[i] = *(const unsigned*)(Y2 + row * (2 * DRNN) + DRNN + n * 128 + cp);
            pf[i] = (smp && psf >= 1) ? *(const unsigned*)(PG + (row - NPROMPT) * (2 * DRNN) + n * 128 + cp) : 0u;
            pb[i] = (smp && psb >= 1) ? *(const unsigned*)(PG + (row - NPROMPT) * (2 * DRNN) + DRNN + n * 128 + cp) : 0u; }
#pragma unroll
        for (int i = 0; i < 16; ++i) { const size_t row = (size_t)(mb + 8 * i + r8);
            const float s0 = (bflo(yf[i]) + bflo(pf[i]) * hf0) + (bflo(yb[i]) + bflo(pb[i]) * hb0), s1 = (bfhi(yf[i]) + bfhi(pf[i]) * hf1) + (bfhi(yb[i]) + bfhi(pb[i]) * hb1);
            *(unsigned*)(Y2 + row * (2 * DRNN) + n * 128 + cp) = cvt_pk_bf16(s0, s1); }
    }
}

#define GLA_ROW(tp_) (rbase + ((tp_) & rmask) * rmul + ((tp_) >> rshift))
__device__ __forceinline__ void phase_gla_pre(const Args& a, LAS unsigned char* lds) {
    const int tid = threadIdx.x, lane = tid & 63, w = tid >> 6, l15 = lane & 15, lq = lane >> 4;
    unsigned char* ws = a.ws;
    const bf16* PROJ = (const bf16*)(ws + WS_MIX); const float* Z = (const float*)(ws + WS_Z);
    v4u* QF = (v4u*)(ws + WS_QF); v4u* KF = (v4u*)(ws + WS_KF); float* DEC = (float*)(ws + WS_DEC); v4u* VF = (v4u*)(ws + WS_VF); v4u* PF = (v4u*)(ws + WS_PF);
    LAS unsigned short* QS = (LAS unsigned short*)lds;
    LAS unsigned short* KS = (LAS unsigned short*)(lds + 8704);
    LAS unsigned short* KT = (LAS unsigned short*)(lds + 17408);
    LAS unsigned short* PS = (LAS unsigned short*)(lds + 27648);
    LAS float* ZS = (LAS float*)(lds + 30208);
    LAS float* CS = (LAS float*)(lds + 32256);
    LAS unsigned short* VT = (LAS unsigned short*)(lds + 34304);
    const int dk = tid & 127, ig = tid >> 7;
    const int G = gridDim.x;
    const bool hoist = (G & 7) == 0;
    float w2r[16]; float bg = 0.f;
#define GP_W(g_) do { const int hh_ = (g_) & 3, d_ = ((g_) >> 2) & 1; \
        _Pragma("unroll") for (int q = 0; q < 16; ++q) w2r[q] = a.in[I_GW2][(size_t)(d_ * 16 + q) * 512 + hh_ * 128 + dk]; \
        bg = a.in[I_GBG][d_ * 512 + hh_ * 128 + dk]; } while (0)
    unsigned nq[8], nk[8]; float nz = 0.f; v4u nv0 = (v4u){0u, 0u, 0u, 0u}, nv1 = nv0;
#define GP_LOAD(g_) do { const int hh_ = (g_) & 3, d_ = ((g_) >> 2) & 1, cid_ = (g_) >> 3; \
        const int s_ = (cid_ < 128) ? (cid_ >> 3) : 16 + ((cid_ - 128) >> 6), cf_ = (cid_ < 128) ? (cid_ & 7) : ((cid_ - 128) & 63); \
        const int rbase = (s_ < 16) ? s_ * 256 : NPROMPT + (s_ - 16) * 2048, rmask = (s_ < 16) ? 0x7fffffff : 31, rmul = (s_ < 16) ? 1 : 64, rshift = (s_ < 16) ? 30 : 5; \
        _Pragma("unroll") for (int ii = 0; ii < 8; ++ii) { const int i = 8 * ig + ii; const int m = GLA_ROW(32 * cf_ + (d_ ? 31 - i : i)); \
            nq[ii] = PROJ[(size_t)m * PROJ_LD + hh_ * 128 + dk]; nk[ii] = PROJ[(size_t)m * PROJ_LD + 512 + hh_ * 128 + dk]; } \
        { const int iz = tid >> 4; const int mz = GLA_ROW(32 * cf_ + (d_ ? 31 - iz : iz)); nz = Z[(size_t)mz * 32 + d_ * 16 + (tid & 15)]; \
          const int i = tid & 31, cg = tid >> 5; const int m = GLA_ROW(32 * cf_ + (d_ ? 31 - i : i)); \
          const v4u* vp = (const v4u*)(PROJ + (size_t)m * PROJ_LD + 1024 + hh_ * 256 + cg * 16); nv0 = vp[0]; nv1 = vp[1]; } } while (0)
    if ((int)blockIdx.x < 2048) { GP_LOAD((int)blockIdx.x); if (hoist) GP_W((int)blockIdx.x); }
    for (int g = blockIdx.x; g < 2048; g += G) {
        const int hh = g & 3, d = (g >> 2) & 1, cid = g >> 3;
        if (!hoist) GP_W(g);
        unsigned pq[8], pk_[8];
#pragma unroll
        for (int ii = 0; ii < 8; ++ii) { pq[ii] = nq[ii]; pk_[ii] = nk[ii]; }
        { const int iz = tid >> 4; const int i = tid & 31, cg = tid >> 5;
          const v4u v0 = nv0, v1 = nv1;
          ZS[iz * 16 + (tid & 15)] = nz;
          LAS unsigned short* vt = VT + (cg * 16) * 40 + i;
          vt[0 * 40] = (unsigned short)(v0.x & 0xffffu); vt[1 * 40] = (unsigned short)(v0.x >> 16); vt[2 * 40] = (unsigned short)(v0.y & 0xffffu); vt[3 * 40] = (unsigned short)(v0.y >> 16);
          vt[4 * 40] = (unsigned short)(v0.z & 0xffffu); vt[5 * 40] = (unsigned short)(v0.z >> 16); vt[6 * 40] = (unsigned short)(v0.w & 0xffffu); vt[7 * 40] = (unsigned short)(v0.w >> 16);
          vt[8 * 40] = (unsigned short)(v1.x & 0xffffu); vt[9 * 40] = (unsigned short)(v1.x >> 16); vt[10 * 40] = (unsigned short)(v1.y & 0xffffu); vt[11 * 40] = (unsigned short)(v1.y >> 16);
          vt[12 * 40] = (unsigned short)(v1.z & 0xffffu); vt[13 * 40] = (unsigned short)(v1.z >> 16); vt[14 * 40] = (unsigned short)(v1.w & 0xffffu); vt[15 * 40] = (unsigned short)(v1.w >> 16); }
        if (g + G < 2048) GP_LOAD(g + G);
        LDS_BAR();
        float cum[8]; float run = 0.f;
#pragma unroll
        for (int ii = 0; ii < 8; ++ii) { const int i = 8 * ig + ii; float zz = bg;
#pragma unroll
            for (int q4 = 0; q4 < 4; ++q4) { const f32x4 zv = *(const LAS f32x4*)(ZS + i * 16 + 4 * q4);
                zz += zv[0] * w2r[4 * q4] + zv[1] * w2r[4 * q4 + 1] + zv[2] * w2r[4 * q4 + 2] + zv[3] * w2r[4 * q4 + 3]; }
            const float lg = (fminf(zz, 0.f) - __logf(1.0f + __expf(-fabsf(zz)))) * 0.0625f;
            run += lg; cum[ii] = run; }
        CS[ig * 128 + dk] = run;
        LDS_BAR();
        { float pre = 0.f, tot = 0.f;
#pragma unroll
          for (int g2 = 0; g2 < 4; ++g2) { const float v = CS[g2 * 128 + dk]; tot += v; if (g2 < ig) pre += v; }
          float k2[8];
#pragma unroll
          for (int ii = 0; ii < 8; ++ii) { const int i = 8 * ig + ii; const float b = pre + cum[ii];
              const float qv = __uint_as_float(pq[ii] << 16), kv = __uint_as_float(pk_[ii] << 16);
              QS[i * 136 + dk] = (unsigned short)(cvt_pk_bf16(qv * __expf(b), 0.f) & 0xffffu);
              KS[i * 136 + dk] = (unsigned short)(cvt_pk_bf16(kv * __expf(-b), 0.f) & 0xffffu);
              k2[ii] = kv * __expf(tot - b); }
          *(LAS v4u*)(KT + dk * 40 + 8 * ig) = (v4u){cvt_pk_bf16(k2[0], k2[1]), cvt_pk_bf16(k2[2], k2[3]), cvt_pk_bf16(k2[4], k2[5]), cvt_pk_bf16(k2[6], k2[7])};
          if (ig == 0) DEC[(size_t)g * 128 + dk] = __expf(tot); }
        LDS_BAR();
        if (w < 4) {
            const int mi2 = w >> 1, nj = w & 1; f32x4 sc = (f32x4){0.f, 0.f, 0.f, 0.f};
#pragma unroll
            for (int ks = 0; ks < 4; ++ks) { const bf16x8 aq = *(const LAS bf16x8*)(QS + (16 * mi2 + l15) * 136 + 32 * ks + 8 * lq);
                const bf16x8 bk = *(const LAS bf16x8*)(KS + (16 * nj + l15) * 136 + 32 * ks + 8 * lq);
                sc = __builtin_amdgcn_mfma_f32_16x16x32_bf16(aq, bk, sc, 0, 0, 0); }
#pragma unroll
            for (int rg = 0; rg < 4; ++rg) { const int i = 16 * mi2 + 4 * lq + rg, j = 16 * nj + l15;
                PS[i * 40 + j] = (unsigned short)(cvt_pk_bf16((j <= i) ? sc[rg] : 0.f, 0.f) & 0xffffu); }
        }
        { const int mi = w >> 2, ks = w & 3;
          const v2u lo = *(const LAS v2u*)(QS + (16 * mi + l15) * 136 + 32 * ks + 4 * lq), hi = *(const LAS v2u*)(QS + (16 * mi + l15) * 136 + 32 * ks + 16 + 4 * lq);
          QF[((size_t)g * 8 + w) * 64 + lane] = (v4u){lo.x, lo.y, hi.x, hi.y};
          KF[((size_t)g * 8 + w) * 64 + lane] = *(const LAS v4u*)(KT + (16 * w + l15) * 40 + 8 * lq);
          if (d == 0) {
#pragma unroll
              for (int h2 = 0; h2 < 2; ++h2) { const int nb = 2 * w + h2;
                  VF[((size_t)cid * 64 + hh * 16 + nb) * 64 + lane] = *(const LAS v4u*)(VT + (16 * nb + l15) * 40 + 8 * lq); } } }
        LDS_BAR();
        if (w < 2) PF[((size_t)g * 2 + w) * 64 + lane] = *(const LAS v4u*)(PS + (16 * w + l15) * 40 + 8 * lq);
        LDS_BAR();
    }
#undef GP_W
#undef GP_LOAD
}

__device__ __forceinline__ unsigned rot16(unsigned x) { return (x >> 16) | (x << 16); }
__device__ __forceinline__ void phase_gla_scan(const Args& a, LAS unsigned char* lds) {
    const int tid = threadIdx.x, lane = tid & 63, w = tid >> 6, l15 = lane & 15, lq = lane >> 4;
    unsigned char* ws = a.ws;
    const v4u* QF = (const v4u*)(ws + WS_QF); const v4u* KF = (const v4u*)(ws + WS_KF); const float* DEC = (const float*)(ws + WS_DEC); const v4u* VF = (const v4u*)(ws + WS_VF); const v4u* PF = (const v4u*)(ws + WS_PF);
    const int G = gridDim.x, b = blockIdx.x;
    LAS v4u* RING = (LAS v4u*)lds;
    for (int k = 0;; ++k) {
        const int it = (k & 1) ? k * G + (G - 1 - b) : k * G + b;
        if (it >= 64 + 256) break;
        const bool lng = it < 64; const int r = lng ? it : it - 64;
        const int hh = lng ? ((r >> 2) & 3) : ((r >> 1) & 3), d = lng ? ((r >> 4) & 1) : ((r >> 3) & 1), sq = lng ? (r >> 5) : (r >> 4);
        const bool act = lng ? (w < 4) : true;
        const int sl = lng ? (r & 3) * 4 + (w & 3) : (r & 1) * 8 + w, s = lng ? 16 + sq : sq;
        const int nch = lng ? 64 : 8, cid0 = lng ? 128 + sq * 64 : sq * 8;
        const int rbase = (s < 16) ? s * 256 : NPROMPT + (s - 16) * 2048, rmask = (s < 16) ? 0x7fffffff : 31, rmul = (s < 16) ? 1 : 64, rshift = (s < 16) ? 30 : 5;
        bf16* O = (bf16*)(ws + WS_P) + (size_t)d * TOK * DM + hh * 256 + 16 * sl + l15;
        const int vlane = d ? (l15 + 16 * (3 - lq)) : lane;
        f32x4 sacc[8];
#pragma unroll
        for (int f = 0; f < 8; ++f) {
            if (lng) { const float* sp = a.in[I_SGLA] + (size_t)((sq * 2 + d) * 4 + hh) * 32768 + (size_t)(16 * f + 4 * lq) * 256 + 16 * sl + l15;
                sacc[f] = (f32x4){sp[0], sp[256], sp[512], sp[768]}; }
            else sacc[f] = (f32x4){0.f, 0.f, 0.f, 0.f};
        }
        v4u qn[2][8], vn[2], kst[2], dsx[2], pn[2][2];
        dsx[0] = (v4u){0u, 0u, 0u, 0u}; dsx[1] = (v4u){0u, 0u, 0u, 0u};
#pragma unroll
        for (int u = 0; u < 2; ++u) { vn[u] = (v4u){0u, 0u, 0u, 0u}; pn[u][0] = vn[u]; pn[u][1] = vn[u];
#pragma unroll
            for (int q = 0; q < 8; ++q) qn[u][q] = vn[u]; }
#define GS_LOAD(u_, c_) do { const int cid_ = cid0 + (d ? nch - 1 - (c_) : (c_)); const size_t g_ = ((size_t)cid_ * 2 + d) * 4 + hh; \
        kst[u_] = KF[g_ * 512 + tid]; if (tid < 32) dsx[u_] = *(const v4u*)(DEC + g_ * 128 + 4 * tid); \
        if (act) { _Pragma("unroll") for (int q = 0; q < 8; ++q) qn[u_][q] = QF[(g_ * 8 + q) * 64 + lane]; \
        vn[u_] = VF[((size_t)cid_ * 64 + hh * 16 + sl) * 64 + vlane]; \
        pn[u_][0] = PF[(g_ * 2 + 0) * 64 + lane]; pn[u_][1] = PF[(g_ * 2 + 1) * 64 + lane]; } } while (0)
#define GS_STAGE(slot_, u_) do { RING[(slot_) * 544 + tid] = kst[u_]; if (tid < 32) RING[(slot_) * 544 + 512 + tid] = dsx[u_]; } while (0)
        GS_LOAD(0, 0); GS_LOAD(1, 1);
        GS_STAGE(0, 0);
        LDS_BAR();
        for (int c0 = 0; c0 < nch; c0 += 2) {
#pragma unroll
          for (int u = 0; u < 2; ++u) {
            const int c = c0 + u;
            const int cid = cid0 + (d ? nch - 1 - c : c); const int cf = cid - cid0;
            if (!act) { if (c + 2 < nch) GS_LOAD(u, c + 2); if (c + 1 < nch) GS_STAGE((c + 1) & 1, u ^ 1); LDS_BAR(); continue; }
            v4u qf[8]; f32x4 o[2];
#pragma unroll
            for (int q = 0; q < 8; ++q) qf[q] = qn[u][q];
            v4u vf = vn[u]; const v4u pf0 = pn[u][0], pf1 = pn[u][1];
            if (d) vf = (v4u){rot16(vf.w), rot16(vf.z), rot16(vf.y), rot16(vf.x)};
            const bf16x8 vb = __builtin_bit_cast(bf16x8, vf);
            if (c + 2 < nch) GS_LOAD(u, c + 2);
            o[0] = __builtin_amdgcn_mfma_f32_16x16x32_bf16(__builtin_bit_cast(bf16x8, pf0), vb, (f32x4){0.f, 0.f, 0.f, 0.f}, 0, 0, 0);
            o[1] = __builtin_amdgcn_mfma_f32_16x16x32_bf16(__builtin_bit_cast(bf16x8, pf1), vb, (f32x4){0.f, 0.f, 0.f, 0.f}, 0, 0, 0);
            const LAS v4u* slot = RING + (c & 1) * 544;
#pragma unroll
            for (int ks = 0; ks < 4; ++ks) {
                v4u sb; sb.x = cvt_pk_bf16(sacc[2 * ks][0], sacc[2 * ks][1]); sb.y = cvt_pk_bf16(sacc[2 * ks][2], sacc[2 * ks][3]);
                sb.z = cvt_pk_bf16(sacc[2 * ks + 1][0], sacc[2 * ks + 1][1]); sb.w = cvt_pk_bf16(sacc[2 * ks + 1][2], sacc[2 * ks + 1][3]);
                const bf16x8 sbv = __builtin_bit_cast(bf16x8, sb);
                o[0] = __builtin_amdgcn_mfma_f32_16x16x32_bf16(__builtin_bit_cast(bf16x8, qf[ks]), sbv, o[0], 0, 0, 0);
                o[1] = __builtin_amdgcn_mfma_f32_16x16x32_bf16(__builtin_bit_cast(bf16x8, qf[4 + ks]), sbv, o[1], 0, 0, 0);
            }
#pragma unroll
            for (int mi = 0; mi < 2; ++mi)
#pragma unroll
                for (int rg = 0; rg < 4; ++rg) { const int i = 16 * mi + 4 * lq + rg; O[(size_t)GLA_ROW(32 * cf + (d ? 31 - i : i)) * DM] = (bf16)(cvt_pk_bf16(o[mi][rg], 0.f) & 0xffffu); }
#pragma unroll
            for (int f = 0; f < 8; ++f) { const v4u kfv = slot[f * 64 + lane]; const f32x4 dec = *(const LAS f32x4*)((const LAS float*)(slot + 512) + 16 * f + 4 * lq);
                sacc[f] = sacc[f] * dec; sacc[f] = __builtin_amdgcn_mfma_f32_16x16x32_bf16(__builtin_bit_cast(bf16x8, kfv), vb, sacc[f], 0, 0, 0); }
            if (c + 1 < nch) GS_STAGE((c + 1) & 1, u ^ 1);
            LDS_BAR();
          }
        }
#undef GS_LOAD
#undef GS_STAGE
        if (!lng) {
#pragma unroll
            for (int f = 0; f < 8; ++f) { float* dp = a.out + OUT_GLA + (size_t)((s * 2 + d) * 4 + hh) * 32768 + (size_t)(16 * f + 4 * lq) * 256 + 16 * sl + l15;
                dp[0] = sacc[f][0]; dp[256] = sacc[f][1]; dp[512] = sacc[f][2]; dp[768] = sacc[f][3]; }
        }
    }
}

__device__ __forceinline__ void phase_gla_norm(const Args& a) {
    const int tid = threadIdx.x, lane = tid & 63, wave = tid >> 6;
    const int gw = blockIdx.x * 8 + wave, NGW = gridDim.x * 8;
    const bf16* Of = (const bf16*)(a.ws + WS_P); const bf16* Ob = Of + (size_t)TOK * DM;
    const bf16* PROJ = (const bf16*)(a.ws + WS_MIX); bf16* AO = (bf16*)(a.ws + WS_XN);
    const bool aff = (gridDim.x == 256);
    const int affm0 = 2048 * ((blockIdx.x & 7) >> 1) + 32 * ((blockIdx.x & 1) * 32 + (blockIdx.x >> 3)) + 4 * wave;
    for (int m0 = aff ? affm0 : gw * 4; m0 < TOK; m0 += aff ? TOK : NGW * 4) {
        f32x4 gn[4];
#pragma unroll
        for (int j = 0; j < 4; ++j) gn[j] = ((const f32x4*)a.in[I_GNORM])[lane + 64 * j];
#pragma unroll 2
        for (int r = 0; r < 4; ++r) {
            const int m = m0 + r;
#pragma unroll
            for (int j = 0; j < 4; ++j) {
                const v2u of = ((const v2u*)(Of + (size_t)m * DM))[lane + 64 * j], ob = ((const v2u*)(Ob + (size_t)m * DM))[lane + 64 * j];
                const f32x4 v = (f32x4){bflo(of.x) + bflo(ob.x), bfhi(of.x) + bfhi(ob.x), bflo(of.y) + bflo(ob.y), bfhi(of.y) + bfhi(ob.y)};
                const float ss = wave_sum((v[0] * v[0] + v[1] * v[1]) + (v[2] * v[2] + v[3] * v[3]));
                const float rstd = 1.0f / sqrtf(ss * (1.0f / 256.0f) + EPS);
                const v2u sr = *(const v2u*)(PROJ + (size_t)m * PROJ_LD + 2048 + 256 * j + 4 * lane);
                v2u wv; wv.x = cvt_pk_bf16(v[0] * rstd * gn[j][0] * bflo(sr.x), v[1] * rstd * gn[j][1] * bfhi(sr.x));
                wv.y = cvt_pk_bf16(v[2] * rstd * gn[j][2] * bflo(sr.y), v[3] * rstd * gn[j][3] * bfhi(sr.y));
                ((v2u*)(AO + (size_t)m * DM))[lane + 64 * j] = wv;
            }
        }
    }
}

#define XB_TMO      128
#define XB_XCNT(j)  (256  + 64 * (j))
#define XB_XSUB(j)  (1280 + 64 * (j))
#define XB_XGEN(j)  (2304 + 64 * (j))
#define XB_TOP      3328
#define XB_TOPGEN   3392
#define XCD_BAR_WORDS 3456
#define XB_SPIN_CAP (1u << 18)
__device__ __forceinline__ unsigned xb_ld(unsigned* p)              { return __hip_atomic_load(p, __ATOMIC_RELAXED, __HIP_MEMORY_SCOPE_AGENT); }
__device__ __forceinline__ unsigned xb_add(unsigned* p, unsigned v) { return __hip_atomic_fetch_add(p, v, __ATOMIC_RELAXED, __HIP_MEMORY_SCOPE_AGENT); }
__device__ __forceinline__ unsigned xb_xcc_id() { return (unsigned)__builtin_amdgcn_s_getreg((3 << 11) | 20) & 0xFu; }
#define XB_SPIN(cond, bar) do { unsigned _sp = 0; while (cond) { __builtin_amdgcn_s_sleep(1); \
    if ((++_sp & 255u) == 0u) { if (xb_ld(&(bar)[XB_TMO])) break; if (_sp > XB_SPIN_CAP) { atomicAdd(&(bar)[XB_TMO], 1u); break; } } } } while (0)
struct XcdBarrier { unsigned* bar; unsigned x; volatile LAS unsigned* st; };
__device__ __forceinline__ XcdBarrier xcd_barrier_post(unsigned* bar, volatile LAS unsigned* st) {
    XcdBarrier b; b.bar = bar; b.x = xb_xcc_id(); b.st = st;
    if (threadIdx.x == 0) (void)xb_add(&bar[XB_XCNT(b.x)], 1u);
    return b;
}
__device__ __forceinline__ void xcd_barrier_complete(unsigned* bar, unsigned x, unsigned& nloc, unsigned& nx) {
    const unsigned G = gridDim.x * gridDim.y * gridDim.z;
    unsigned sum, cnt, mine, sp = 0u;
    for (;;) {
        sum = 0u; cnt = 0u; mine = 0u;
#pragma unroll
        for (unsigned j = 0; j < 16; ++j) { const unsigned c = xb_ld(&bar[XB_XCNT(j)]); sum += c; cnt += (c > 0u) ? 1u : 0u; mine = (j == x) ? c : mine; }
        if (sum == G) break;
        __builtin_amdgcn_s_sleep(1);
        if ((++sp & 255u) == 0u) { if (xb_ld(&bar[XB_TMO])) break; if (sp > XB_SPIN_CAP) { atomicAdd(&bar[XB_TMO], 1u); break; } }
    }
    nloc = mine > 0u ? mine : 1u; nx = cnt > 0u ? cnt : 1u;
}
__device__ __forceinline__ void xcd_barrier(const XcdBarrier& b) {
    asm volatile("s_waitcnt vmcnt(0)" ::: "memory");
    __syncthreads();
    if (threadIdx.x == 0) {
        unsigned* bar = b.bar;
        __builtin_amdgcn_s_waitcnt(0);
        unsigned nloc = b.st[0], nx = b.st[1];
        if (nloc == 0u) { xcd_barrier_complete(bar, b.x, nloc, nx); b.st[0] = nloc; b.st[1] = nx; }
        const unsigned old = xb_add(&bar[XB_XSUB(b.x)], 1u);
        const unsigned gen = old / nloc;
        if (old + 1u == (gen + 1u) * nloc) {
            __builtin_amdgcn_fence(__ATOMIC_RELEASE, "agent");
            asm volatile("s_waitcnt vmcnt(0)" ::: "memory");
            const unsigned og = xb_add(&bar[XB_TOP], 1u);
            const unsigned tg = og / nx;
            if (og + 1u == (tg + 1u) * nx) xb_add(&bar[XB_TOPGEN], 1u);
            else XB_SPIN(xb_ld(&bar[XB_TOPGEN]) == tg, bar);
            __builtin_amdgcn_fence(__ATOMIC_ACQUIRE, "agent");
            xb_add(&bar[XB_XGEN(b.x)], 1u);
            asm volatile("s_waitcnt vmcnt(0)" ::: "memory");
        } else {
            XB_SPIN(xb_ld(&bar[XB_XGEN(b.x)]) == gen, bar);
            __builtin_amdgcn_fence(__ATOMIC_ACQUIRE, "agent");
            asm volatile("s_waitcnt vmcnt(0)" ::: "memory");
        }
    }
    __syncthreads();
}

constexpr int LDS_BYTES = pg8::STAGE_BYTES + 64;
constexpr int N_PHASES = 25;

__global__ void __launch_bounds__(512, 2) fwd_megakernel(Args args) {
    extern __shared__ __attribute__((aligned(16))) unsigned char lds_raw[];
    LAS unsigned char* lds = (LAS unsigned char*)lds_raw;
    cg::grid_group grid = cg::this_grid();
    unsigned char* ws = args.ws;
    const int lo = args.ph_lo, hi = args.ph_hi;
    const int G = gridDim.x, bx = blockIdx.x;
    unsigned* barw = (unsigned*)ws;
    volatile LAS unsigned* bst = (volatile LAS unsigned*)(lds + pg8::STAGE_BYTES);
    if (threadIdx.x == 0) { bst[0] = 0u; bst[1] = 0u; }
    __syncthreads();
    XcdBarrier xbar = xcd_barrier_post(barw, bst);
    if (hi > 1000000) grid.sync();
#define IN(k) (lo <= (k) && (k) < hi)
#define DUP(k) ((DUP_MASK >> (k)) & 1u)
#define RUN(k, ...) do { if (IN(k)) { __VA_ARGS__; if (DUP(k)) { __syncthreads(); __VA_ARGS__; } } } while (0)
#define SEAM(k) do { if (IN(k) && IN((k) + 1)) { xcd_barrier(xbar); } } while (0)

#define GEMM_FFN_IN(mi) do { pg8::Gemm g{(const bf16*)(ws + WS_XN), (const bf16*)(ws + WS_WFI) + (size_t)(mi) * 5632 * 1024, 1024, 1024, 1024, 0, 0}; \
        pg8::Order S; S.init(TOK, 5632, 1, G, bx); pg8::EpiSwiglu E{(bf16*)(ws + WS_HID)}; pg8::gemm_phase<pg8::EpiSwiglu>(lds, g, S, E); } while (0)
#define GEMM_FFN_OUT(mi) do { pg8::Gemm g{(const bf16*)(ws + WS_HID), (const bf16*)(ws + WS_WFO) + (size_t)(mi) * 1024 * 2816, 1408, 2816, 2816, 1408, 1408}; \
        pg8::Order S; S.init(TOK, 1024, 2, G, bx); pg8::EpiPart E{(bf16*)(ws + WS_P)}; pg8::gemm_phase<pg8::EpiPart>(lds, g, S, E); } while (0)

    RUN(0, phase_prep(args, lds);); SEAM(0);
    RUN(1, phase_combine(args, 1, 0, 0, 0, 0.f, 0, 0);); SEAM(1);
    RUN(2, GEMM_FFN_IN(0); if (G == 256 && bx >= 192) ada_items(args, lds, 144 + (bx - 192), 64, 216);); SEAM(2);
    RUN(3, GEMM_FFN_OUT(0);); SEAM(3);
    RUN(4, phase_combine(args, 0, 0, 0, 0, 0.5f, 0, 1);); SEAM(4);
    RUN(5, { pg8::Gemm g{(const bf16*)(ws + WS_XN), (const bf16*)(ws + WS_WRI), 1024, 1024, 1024, 0, 0};
        pg8::Order S; S.init(TOK, 2560, 1, G, bx); pg8::EpiRgIn E{(bf16*)(ws + WS_MIX), (bf16*)(ws + WS_P)}; pg8::gemm_phase<pg8::EpiRgIn>(lds, g, S, E);
        if (G == 256 && bx >= 64) { const int gw_ = (bx - 64) * 8 + (int)(threadIdx.x >> 6); convert_weights(args, lds, 1, gw_, 192 * 8, 0x7fffffff, gw_, 192 * 8); } }); SEAM(5);

    RUN(6, phase_rg(args, lds);); SEAM(6);
    RUN(7, phase_rg_fix(args);); SEAM(7);
    RUN(8, { pg8::Gemm g{(const bf16*)(ws + WS_HID), (const bf16*)(ws + WS_WRO), 640, 2560, 1280, 640, 640};
        pg8::Order S; S.init(TOK, 1024, 2, G, bx); pg8::EpiPart E{(bf16*)(ws + WS_P)}; pg8::gemm_phase<pg8::EpiPart>(lds, g, S, E); }); SEAM(8);
    RUN(9, phase_combine(args, 0, 0, 0, 1, 1.0f, 0, 2);); SEAM(9);
    RUN(10, GEMM_FFN_IN(1); if (G == 256 && bx >= 192) ada_items(args, lds, 216 + (bx - 192), 64, 288);); SEAM(10);
    RUN(11, GEMM_FFN_OUT(1);); SEAM(11);
    RUN(12, phase_combine(args, 0, 0, 0, 2, 0.5f, 1, 0);); SEAM(12);
    RUN(13, GEMM_FFN_IN(2);); SEAM(13);
    RUN(14, GEMM_FFN_OUT(2);); SEAM(14);
    RUN(15, phase_combine(args, 0, 0, 1, 0, 0.5f, 1, 1);); SEAM(15);
    RUN(16, { pg8::Gemm g{(const bf16*)(ws + WS_XN), (const bf16*)(ws + WS_WGI), 1024, 1024, 1024, 0, 0};
        pg8::Order S; S.init(TOK, GLA_NP, 1, G, bx); pg8::EpiGlaIn E{(bf16*)(ws + WS_MIX), (float*)(ws + WS_Z)}; pg8::gemm_phase<pg8::EpiGlaIn>(lds, g, S, E); }); SEAM(16);
    RUN(17, phase_gla_pre(args, lds);); SEAM(17);
    RUN(18, phase_gla_scan(args, lds); if (G == 256 && bx >= 64) { __syncthreads(); const int gw_ = (bx - 64) * 8 + (int)(threadIdx.x >> 6); convert_weights(args, lds, 2, gw_, 192 * 8, 0x7fffffff, gw_, 192 * 8); }); SEAM(18);
    RUN(19, phase_gla_norm(args);); SEAM(19);
    RUN(20, { pg8::Gemm g{(const bf16*)(ws + WS_XN), (const bf16*)(ws + WS_WGO), 512, 1024, 1024, 512, 512};
        pg8::Order S; S.init(TOK, 1024, 2, G, bx); pg8::EpiPart E{(bf16*)(ws + WS_P)}; pg8::gemm_phase<pg8::EpiPart>(lds, g, S, E); }); SEAM(20);
    RUN(21, phase_combine(args, 0, 0, 1, 1, 1.0f, 1, 2);); SEAM(21);
    RUN(22, GEMM_FFN_IN(3);); SEAM(22);
    RUN(23, GEMM_FFN_OUT(3);); SEAM(23);
    RUN(24, phase_combine(args, 0, 1, 1, 2, 0.5f, 0, 0););
#undef IN
#undef SEAM
}

extern "C" void kernel_launch(void* const* d_in, const int* in_sizes, int n_in, void* d_out, int out_size, void* d_ws, size_t ws_size, hipStream_t stream) {
    static int grid = 0;
    if (grid == 0) {
        if (n_in != 26 || ws_size < WS_END) { fprintf(stderr, "kernel_launch: expected 26 inputs and >= %zu bytes of workspace (got %d, %zu)\n", (size_t)WS_END, n_in, ws_size); grid = -1; return; }
        int dev = 0, cus = 0, per_cu = 0;
        if (hipGetDevice(&dev) != hipSuccess || hipDeviceGetAttribute(&cus, hipDeviceAttributeMultiprocessorCount, dev) != hipSuccess) { grid = -1; return; }
        if (hipFuncSetAttribute((const void*)fwd_megakernel, hipFuncAttributeMaxDynamicSharedMemorySize, LDS_BYTES) != hipSuccess) { fprintf(stderr, "kernel_launch: hipFuncSetAttribute failed\n"); grid = -1; return; }
        if (hipOccupancyMaxActiveBlocksPerMultiprocessor(&per_cu, (const void*)fwd_megakernel, 512, LDS_BYTES) != hipSuccess || per_cu < 1) { fprintf(stderr, "kernel_launch: occupancy query failed (%d)\n", per_cu); (void)hipGetLastError(); grid = -1; return; }
        grid = cus;
    }
    if (grid < 0) return;
    if (hipMemsetAsync(d_ws, 0, 16384, stream) != hipSuccess) { fprintf(stderr, "kernel_launch: hipMemsetAsync of the barrier words failed\n"); return; }
    Args a{};
    for (int i = 0; i < 26; ++i) a.in[i] = (const float*)d_in[i];
    a.out = (float*)d_out; a.ws = (unsigned char*)d_ws;
    a.ph_lo = 0; a.ph_hi = N_PHASES; void* kargs[] = {&a};
    hipError_t e = hipLaunchCooperativeKernel((const void*)fwd_megakernel, dim3(grid), dim3(512), kargs, LDS_BYTES, stream);
    if (e != hipSuccess) fprintf(stderr, "kernel_launch: cooperative launch failed: %s (grid %d)\n", hipGetErrorString(e), grid);
}
```

```cpp
#include <hip/hip_runtime.h>
#include <hip/hip_cooperative_groups.h>
#include <cstdio>
#include <cstdint>
namespace cg = cooperative_groups;


#ifndef DUP_MASK
#define DUP_MASK 0u
#endif
#define GAS __attribute__((address_space(1)))
#define LAS __attribute__((address_space(3)))
typedef unsigned short bf16;
typedef unsigned v4u __attribute__((ext_vector_type(4)));
typedef unsigned v2u __attribute__((ext_vector_type(2)));
typedef float f32x4 __attribute__((ext_vector_type(4)));
typedef float f32x2 __attribute__((ext_vector_type(2)));
typedef short bf16x8 __attribute__((ext_vector_type(8)));

constexpr int DM = 1024, TOK = 8192, NPROMPT = 4096, DFF = 2816, DRNN = 1280;
constexpr int GLA_N = 3104, GLA_NP = 3328, PROJ_LD = 3072;
constexpr float EPS = 1e-6f;
constexpr size_t OUT_RG = (size_t)TOK * DM, OUT_GLA = OUT_RG + 16 * 2 * 1280;

constexpr size_t MiB = 1u << 20;
constexpr size_t WS_MOD = MiB / 2;
constexpr size_t WS_WFI = 1 * MiB;
constexpr size_t WS_WFO = 45 * MiB;
constexpr size_t WS_WRI = 67 * MiB;
constexpr size_t WS_WRO = 72 * MiB;
constexpr size_t WS_WGI = 75 * MiB;
constexpr size_t WS_WGO = 82 * MiB;
constexpr size_t WS_WGT = 84 * MiB;
constexpr size_t WS_XN  = 86 * MiB;
constexpr size_t WS_P   = 102 * MiB;
constexpr size_t WS_HID = 166 * MiB;
constexpr size_t WS_MIX = 210 * MiB;
constexpr size_t WS_Z   = WS_MIX + 48 * MiB;
constexpr size_t WS_PG  = 230 * MiB;
constexpr size_t WS_SEG = 259 * MiB;
constexpr size_t WS_QF = 166 * MiB, WS_KF = 182 * MiB, WS_DEC = 198 * MiB, WS_PF = 199 * MiB;
constexpr size_t WS_VF = 260 * MiB;
constexpr size_t WS_END = 276 * MiB;

typedef __bf16 bf16x2_t __attribute__((ext_vector_type(2)));
__device__ __forceinline__ unsigned cvt_pk_bf16(float lo, float hi) { f32x2 v = {lo, hi}; bf16x2_t b = __builtin_convertvector(v, bf16x2_t); return __builtin_bit_cast(unsigned, b); }
__device__ __forceinline__ float bf2f(unsigned short b) { return __uint_as_float(((unsigned)b) << 16); }
__device__ __forceinline__ float bflo(unsigned u) { return __uint_as_float(u << 16); }
__device__ __forceinline__ float bfhi(unsigned u) { return __uint_as_float(u & 0xffff0000u); }
__device__ __forceinline__ float fast_sigmoid(float x) { return __builtin_amdgcn_rcpf(1.0f + __expf(-x)); }
__device__ __forceinline__ float silu_f(float x) { return x * fast_sigmoid(x); }
__device__ __forceinline__ float gelu_tanh_f(float x) { return x * fast_sigmoid(1.5957691216057308f * (x + 0.044715f * x * x * x)); }
__device__ __forceinline__ float dpp_add(float v, const int ctrl_sel) {
    int r;
    switch (ctrl_sel) {
        case 0:  r = __builtin_amdgcn_update_dpp(0, __builtin_bit_cast(int, v), 0xB1, 0xF, 0xF, true); break;
        case 1:  r = __builtin_amdgcn_update_dpp(0, __builtin_bit_cast(int, v), 0x4E, 0xF, 0xF, true); break;
        case 2:  r = __builtin_amdgcn_update_dpp(0, __builtin_bit_cast(int, v), 0x141, 0xF, 0xF, true); break;
        default: r = __builtin_amdgcn_update_dpp(0, __builtin_bit_cast(int, v), 0x140, 0xF, 0xF, true); break;
    }
    return v + __builtin_bit_cast(float, r);
}
__device__ __forceinline__ float wave_sum(float v) {
    v = dpp_add(v, 0); v = dpp_add(v, 1); v = dpp_add(v, 2); v = dpp_add(v, 3);
    const int iv = __builtin_bit_cast(int, v);
    const float r0 = __builtin_bit_cast(float, __builtin_amdgcn_readlane(iv, 0)), r1 = __builtin_bit_cast(float, __builtin_amdgcn_readlane(iv, 16));
    const float r2 = __builtin_bit_cast(float, __builtin_amdgcn_readlane(iv, 32)), r3 = __builtin_bit_cast(float, __builtin_amdgcn_readlane(iv, 48));
    return (r0 + r1) + (r2 + r3);
}
#define LDS_BAR() do { asm volatile("s_waitcnt lgkmcnt(0)" ::: "memory"); __builtin_amdgcn_s_barrier(); asm volatile("" ::: "memory"); } while (0)
namespace pg8 {
#define PG8_LAS __attribute__((address_space(3)))
typedef unsigned short bf16_t;
constexpr int BM = 256, BK = 64, HALF = 128, HTB = HALF * BK * 2, STAGE_BYTES = 8 * HTB, NXCD = 8, WGM = 8;

__host__ __device__ __forceinline__ int lds_byte(int r, int c) { const int st = (r >> 4) * 2 + (c >> 5), rr = r & 15, cc = c & 31, ob = rr * 64 + cc * 2; return st * 1024 + (ob ^ (((ob >> 9) & 1) << 5)); }
__host__ __device__ __forceinline__ void stage_rc(int b, int& R, int& C) { const int st = b / 1024, sb = b % 1024, swz = sb ^ (((sb >> 9) & 1) << 5); R = (st >> 1) * 16 + swz / 64; C = (st & 1) * 32 + (swz % 64) / 2; }
__host__ __device__ __forceinline__ int perm32(int rho) { const int n = rho >> 4, i = rho & 15; return 8 * (i >> 2) + 4 * n + (i & 3); }

struct Unit { int pm, pn, ks; };
struct Gemm { const bf16_t* A; const bf16_t* Bt; int K, lda, ldb, ksA, ksB; };

struct Order {
    int nM, nNv, nNr, nwg, G, c;
    __device__ void init(int M, int Nreal, int nsplit, int G_, int c_) { nM = M / BM; nNr = Nreal / BM; nNv = nNr * nsplit; nwg = nM * nNv; G = G_; c = c_; }
    __device__ bool next(int i, Unit& u) const {
        const long L = (long)i * G + c; if (L >= nwg) return false;
        int wgid = (int)L; { const int q = nwg / NXCD, r = nwg % NXCD, xcd = wgid % NXCD, off = wgid / NXCD; wgid = (xcd < r ? xcd * (q + 1) : r * (q + 1) + (xcd - r) * q) + off; }
        const int nig = WGM * nNv, gid = wgid / nig, fm = gid * WGM, gsz = (nM - fm) < WGM ? (nM - fm) : WGM;
        u.pm = fm + ((wgid % nig) % gsz); const int pv = (wgid % nig) / gsz; u.pn = pv % nNr; u.ks = pv / nNr; return true;
    }
};

template <class Epi>
__device__ __forceinline__ void gemm_phase(PG8_LAS unsigned char* lds, const Gemm g, const Order& S, const Epi& E) {
    const int tid = threadIdx.x, wid = __builtin_amdgcn_readfirstlane(tid >> 6), lane = tid & 63, wr = wid >> 2, wc = wid & 3, fr = lane & 15, fq = lane >> 4;
    const int K = g.K, nt = K / BK;
    unsigned voffA[2], voffB[2];
#pragma unroll
    for (int i = 0; i < 2; ++i) { int R, C; stage_rc(tid * 16 + i * 8192, R, C); const int Rb = Epi::PERM ? ((R & ~31) + perm32(R & 31)) : R;
        voffA[i] = (unsigned)(R * g.lda + C) * 2u; voffB[i] = (unsigned)(Rb * g.ldb + C) * 2u; }
    const size_t kstep = (size_t)(BK * 2);
    const size_t hstepA = (size_t)HALF * g.lda * 2, hstepB = (size_t)HALF * g.ldb * 2;
    const unsigned ldsw = (unsigned)wid * 1024u;
    const int aoff = lds_byte(wr * 64 + fr, fq * 8), boff = lds_byte(wc * 32 + fr, fq * 8);
#define PG8_SA(b, h) (((b) * 2 + (h)) * HTB)
#define PG8_SB(b, h) ((4 + (b) * 2 + (h)) * HTB)
#define PG8_STAGE(bufoff, gbase, voff) do { _Pragma("unroll") for (int _i = 0; _i < 2; ++_i) \
        __builtin_amdgcn_global_load_lds((const unsigned*)((const char*)(gbase) + (voff)[_i]), (PG8_LAS unsigned*)(lds + (bufoff) + ldsw + _i * 8192), 16, 0, 0); } while (0)
#define PG8_LDA(dst, b, h) do { _Pragma("unroll") for (int m = 0; m < 4; ++m) _Pragma("unroll") for (int k = 0; k < 2; ++k) dst[m][k] = *(const PG8_LAS bf16x8*)(lds + PG8_SA(b, h) + aoff + m * 2048 + k * 1024); } while (0)
#define PG8_LDB(dst, b, h) do { _Pragma("unroll") for (int n = 0; n < 2; ++n) _Pragma("unroll") for (int k = 0; k < 2; ++k) dst[n][k] = *(const PG8_LAS bf16x8*)(lds + PG8_SB(b, h) + boff + n * 2048 + k * 1024); } while (0)
#define PG8_MMA(ai, bj, At, Bt) do { __builtin_amdgcn_s_setprio(1); _Pragma("unroll") for (int m = 0; m < 4; ++m) _Pragma("unroll") for (int n = 0; n < 2; ++n) _Pragma("unroll") for (int k = 0; k < 2; ++k) \
        acc[ai][bj][m][n] = __builtin_amdgcn_mfma_f32_16x16x32_bf16(Bt[n][k], At[m][k], acc[ai][bj][m][n], 0, 0, 0); __builtin_amdgcn_s_setprio(0); } while (0)
#define PG8_WAIT_V(n) asm volatile("s_waitcnt vmcnt(" #n ")" ::: "memory")
#define PG8_WAIT_L(n) asm volatile("s_waitcnt lgkmcnt(" #n ")" ::: "memory")
#define PG8_BAR __builtin_amdgcn_s_barrier()
#define PG8_SCHED __builtin_amdgcn_sched_barrier(0)
#define PG8_UA(u) ((const char*)g.A + (size_t)(u).pm * 2 * hstepA + (size_t)(u).ks * g.ksA * 2)
#define PG8_UB(u) ((const char*)g.Bt + (size_t)(u).pn * 2 * hstepB + (size_t)(u).ks * g.ksB * 2)
    Unit cur, nxt; int ui = 0;
    if (!S.next(0, cur)) return;
    f32x4 acc[2][2][4][2];
#pragma unroll
    for (int a = 0; a < 2; ++a)
#pragma unroll
        for (int b = 0; b < 2; ++b)
#pragma unroll
            for (int m = 0; m < 4; ++m)
#pragma unroll
                for (int n = 0; n < 2; ++n) acc[a][b][m][n] = (f32x4){0.f, 0.f, 0.f, 0.f};
    bf16x8 At[4][2], B0[2][2], B1[2][2];
    const char* cA = PG8_UA(cur); const char* cB = PG8_UB(cur);
    PG8_STAGE(PG8_SB(0, 0), cB, voffB); PG8_STAGE(PG8_SB(0, 1), cB + hstepB, voffB); PG8_STAGE(PG8_SA(0, 0), cA, voffA); PG8_STAGE(PG8_SA(0, 1), cA + hstepA, voffA);
    if (wr == 1) PG8_BAR;
    PG8_WAIT_V(2); PG8_BAR;
    PG8_STAGE(PG8_SB(1, 0), cB + kstep, voffB); PG8_STAGE(PG8_SA(1, 0), cA + kstep, voffA); PG8_STAGE(PG8_SB(1, 1), cB + hstepB + kstep, voffB);
    PG8_WAIT_V(6); PG8_BAR;
    for (;;) {
        const bool has_next = S.next(ui + 1, nxt);
        const char* nA = has_next ? PG8_UA(nxt) : cA; const char* nB = has_next ? PG8_UB(nxt) : cB;
        for (int t = 0; t < nt; t += 2) {
            const bool last = (t == nt - 2);
            const char* a1 = cA + (size_t)(t + 1) * kstep;
            const char* a2 = last ? nA : cA + (size_t)(t + 2) * kstep; const char* b2 = last ? nB : cB + (size_t)(t + 2) * kstep;
            const char* a3 = a2 + kstep; const char* b3 = b2 + kstep;
            PG8_LDB(B0, 0, 0); PG8_LDB(B1, 0, 1); PG8_SCHED; PG8_LDA(At, 0, 0); PG8_STAGE(PG8_SA(1, 1), a1 + hstepA, voffA);
            PG8_WAIT_V(8); PG8_WAIT_L(0); PG8_BAR; PG8_MMA(0, 0, At, B0); PG8_MMA(0, 1, At, B1); PG8_BAR; PG8_SCHED;
            PG8_LDA(At, 0, 1); PG8_STAGE(PG8_SB(0, 0), b2, voffB); PG8_STAGE(PG8_SB(0, 1), b2 + hstepB, voffB); PG8_STAGE(PG8_SA(0, 0), a2, voffA);
            PG8_WAIT_V(8); PG8_WAIT_L(0); PG8_BAR; PG8_MMA(1, 0, At, B0); PG8_MMA(1, 1, At, B1); PG8_BAR; PG8_SCHED;
            PG8_LDB(B0, 1, 0); PG8_LDB(B1, 1, 1); PG8_SCHED; PG8_LDA(At, 1, 0); PG8_STAGE(PG8_SA(0, 1), a2 + hstepA, voffA);
            PG8_WAIT_V(8); PG8_WAIT_L(0); PG8_BAR; PG8_MMA(0, 0, At, B0); PG8_MMA(0, 1, At, B1); PG8_BAR; PG8_SCHED;
            PG8_LDA(At, 1, 1); PG8_STAGE(PG8_SB(1, 0), b3, voffB); PG8_STAGE(PG8_SB(1, 1), b3 + hstepB, voffB); PG8_STAGE(PG8_SA(1, 0), a3, voffA);
            PG8_WAIT_V(8); PG8_WAIT_L(0); PG8_BAR; PG8_MMA(1, 0, At, B0); PG8_MMA(1, 1, At, B1); PG8_BAR; PG8_SCHED;
        }
        if (wr == 0) PG8_BAR;
        E(acc, cur, wr, wc, fr, fq);
        if (!has_next) break;
#pragma unroll
        for (int a = 0; a < 2; ++a)
#pragma unroll
            for (int b = 0; b < 2; ++b)
#pragma unroll
                for (int m = 0; m < 4; ++m)
#pragma unroll
                    for (int n = 0; n < 2; ++n) acc[a][b][m][n] = (f32x4){0.f, 0.f, 0.f, 0.f};
        cur = nxt; cA = nA; cB = nB; ++ui;
        if (wr == 1) PG8_BAR;
    }
    PG8_WAIT_V(0);
    PG8_BAR;
#undef PG8_SA
#undef PG8_SB
#undef PG8_STAGE
#undef PG8_LDA
#undef PG8_LDB
#undef PG8_MMA
#undef PG8_WAIT_V
#undef PG8_WAIT_L
#undef PG8_BAR
#undef PG8_SCHED
#undef PG8_UA
#undef PG8_UB
}

struct EpiSwiglu {
    static constexpr bool PERM = true;
    bf16_t* H;
    __device__ __forceinline__ void operator()(const f32x4 (&acc)[2][2][4][2], const Unit& u, int wr, int wc, int fr, int fq) const {
        const int row0 = u.pm * BM + wr * 64 + fr, colh = u.pn * 128 + wc * 32 + 8 * fq;
#pragma unroll
        for (int ai = 0; ai < 2; ++ai)
#pragma unroll
            for (int m = 0; m < 4; ++m) {
                const f32x4 g0 = acc[ai][0][m][0], g1 = acc[ai][0][m][1], u0 = acc[ai][1][m][0], u1 = acc[ai][1][m][1];
                v4u w;
                w.x = cvt_pk_bf16(silu_f(g0[0]) * u0[0], silu_f(g0[1]) * u0[1]); w.y = cvt_pk_bf16(silu_f(g0[2]) * u0[2], silu_f(g0[3]) * u0[3]);
                w.z = cvt_pk_bf16(silu_f(g1[0]) * u1[0], silu_f(g1[1]) * u1[1]); w.w = cvt_pk_bf16(silu_f(g1[2]) * u1[2], silu_f(g1[3]) * u1[3]);
                *(v4u*)(H + (size_t)(row0 + ai * HALF + m * 16) * DFF + colh) = w;
            }
    }
};
struct EpiPart {
    static constexpr bool PERM = true;
    bf16_t* P;
    __device__ __forceinline__ void operator()(const f32x4 (&acc)[2][2][4][2], const Unit& u, int wr, int wc, int fr, int fq) const {
        bf16_t* base = P + (size_t)u.ks * TOK * DM + (size_t)(u.pm * BM + wr * 64 + fr) * DM + u.pn * BM + wc * 32 + 8 * fq;
#pragma unroll
        for (int ai = 0; ai < 2; ++ai)
#pragma unroll
            for (int m = 0; m < 4; ++m)
#pragma unroll
                for (int bj = 0; bj < 2; ++bj) { const f32x4 a = acc[ai][bj][m][0], b = acc[ai][bj][m][1];
                    *(v4u*)(base + (size_t)(ai * HALF + m * 16) * DM + bj * HALF) = (v4u){cvt_pk_bf16(a[0], a[1]), cvt_pk_bf16(a[2], a[3]), cvt_pk_bf16(b[0], b[1]), cvt_pk_bf16(b[2], b[3])}; }
    }
};
struct EpiRgIn {
    static constexpr bool PERM = true;
    bf16_t* GG; bf16_t* XBR;
    __device__ __forceinline__ void operator()(const f32x4 (&acc)[2][2][4][2], const Unit& u, int wr, int wc, int fr, int fq) const {
        const int row0 = u.pm * BM + wr * 64 + fr;
        if (u.pn < 5) {
            const int col0 = u.pn * BM + wc * 32 + 8 * fq;
#pragma unroll
            for (int ai = 0; ai < 2; ++ai)
#pragma unroll
                for (int m = 0; m < 4; ++m)
#pragma unroll
                    for (int bj = 0; bj < 2; ++bj) {
                        const f32x4 a = acc[ai][bj][m][0], b = acc[ai][bj][m][1]; v4u w;
                        w.x = cvt_pk_bf16(gelu_tanh_f(a[0]), gelu_tanh_f(a[1])); w.y = cvt_pk_bf16(gelu_tanh_f(a[2]), gelu_tanh_f(a[3]));
                        w.z = cvt_pk_bf16(gelu_tanh_f(b[0]), gelu_tanh_f(b[1])); w.w = cvt_pk_bf16(gelu_tanh_f(b[2]), gelu_tanh_f(b[3]));
                        *(v4u*)(GG + (size_t)(row0 + ai * HALF + m * 16) * DRNN + col0 + bj * HALF) = w;
                    }
        } else {
            const int col0 = (u.pn - 5) * BM + wc * 32 + 8 * fq;
#pragma unroll
            for (int ai = 0; ai < 2; ++ai)
#pragma unroll
                for (int m = 0; m < 4; ++m)
#pragma unroll
                    for (int bj = 0; bj < 2; ++bj) {
                        const f32x4 a = acc[ai][bj][m][0], b = acc[ai][bj][m][1];
                        *(v4u*)(XBR + (size_t)(row0 + ai * HALF + m * 16) * DRNN + col0 + bj * HALF) = (v4u){cvt_pk_bf16(a[0], a[1]), cvt_pk_bf16(a[2], a[3]), cvt_pk_bf16(b[0], b[1]), cvt_pk_bf16(b[2], b[3])};
                    }
        }
    }
};
struct EpiGlaIn {
    static constexpr bool PERM = true;
    bf16_t* PROJ; float* Z;
    __device__ __forceinline__ void operator()(const f32x4 (&acc)[2][2][4][2], const Unit& u, int wr, int wc, int fr, int fq) const {
        const int row0 = u.pm * BM + wr * 64 + fr;
        if (u.pn < 12) {
            const int col0 = u.pn * BM + wc * 32 + 8 * fq;
            const float sc = (u.pn < 2) ? 0.08838834764831845f : 1.0f; const bool act = (u.pn >= 8);
#pragma unroll
            for (int ai = 0; ai < 2; ++ai)
#pragma unroll
                for (int m = 0; m < 4; ++m)
#pragma unroll
                    for (int bj = 0; bj < 2; ++bj) {
                        f32x4 a = acc[ai][bj][m][0] * sc, b = acc[ai][bj][m][1] * sc;
                        if (act) { a = (f32x4){silu_f(a[0]), silu_f(a[1]), silu_f(a[2]), silu_f(a[3])}; b = (f32x4){silu_f(b[0]), silu_f(b[1]), silu_f(b[2]), silu_f(b[3])}; }
                        v4u w; w.x = cvt_pk_bf16(a[0], a[1]); w.y = cvt_pk_bf16(a[2], a[3]); w.z = cvt_pk_bf16(b[0], b[1]); w.w = cvt_pk_bf16(b[2], b[3]);
                        *(v4u*)(PROJ + (size_t)(row0 + ai * HALF + m * 16) * PROJ_LD + col0 + bj * HALF) = w;
                    }
        } else if (wc == 0) {
#pragma unroll
            for (int ai = 0; ai < 2; ++ai)
#pragma unroll
                for (int m = 0; m < 4; ++m) {
                    float* p = Z + (size_t)(row0 + ai * HALF + m * 16) * 32 + 8 * fq;
                    *(f32x4*)p = acc[ai][0][m][0]; *(f32x4*)(p + 4) = acc[ai][0][m][1];
                }
        }
    }
};
}

struct Args { const float* in[26]; float* out; unsigned char* ws; int ph_lo, ph_hi; };
enum { I_XP = 0, I_XS, I_C, I_SRG, I_SGLA, I_CCTX, I_ADAW, I_ADAB, I_NORMG, I_FWI, I_FWO, I_RWI, I_RCW, I_RCB, I_RWA, I_RBA, I_RWIG, I_RBI, I_RLAM, I_RWO,
       I_GWI, I_GW2, I_GBG, I_GNORM, I_GWO, I_FNORM };

__device__ __forceinline__ void transpose_item(const float* W, int N, int k0, int n0, bf16* dst, int ldk, LAS float* scr, int lane) {
    float tv[32];
#pragma unroll
    for (int i = 0; i < 32; ++i) tv[i] = __builtin_nontemporal_load(&W[(size_t)(k0 + 2 * i + (lane >> 5)) * N + n0 + (lane & 31)]);
#pragma unroll
    for (int i = 0; i < 32; ++i) scr[(2 * i + (lane >> 5)) * 33 + (lane & 31)] = tv[i];
    asm volatile("s_waitcnt lgkmcnt(0)" ::: "memory");
    const int c = lane & 7;
#pragma unroll
    for (int j = 0; j < 4; ++j) { const int n = (lane >> 3) + 8 * j; const LAS float* s = scr + (8 * c) * 33 + n;
        v4u o; o.x = cvt_pk_bf16(s[0 * 33], s[1 * 33]); o.y = cvt_pk_bf16(s[2 * 33], s[3 * 33]); o.z = cvt_pk_bf16(s[4 * 33], s[5 * 33]); o.w = cvt_pk_bf16(s[6 * 33], s[7 * 33]);
        *(v4u*)(dst + (size_t)n * ldk + k0 + 8 * c) = o; }
    asm volatile("s_waitcnt lgkmcnt(0)" ::: "memory");
}

__device__ __forceinline__ void ada_items(const Args& a, LAS unsigned char* lds, const int first, const int stride, const int limit) {
    const int tid = threadIdx.x, lane = tid & 63, wave = tid >> 6;
    if (first >= limit) return;
    LAS float* sv = (LAS float*)lds;
    LAS float* red = (LAS float*)(lds + 12288);
    for (int i = tid; i < 3 * 1024; i += 512) { const int g = i >> 10, k = i & 1023; const float v = (g == 0) ? a.in[I_CCTX][k] : a.in[I_C][(g - 1) * 1024 + k]; sv[i] = silu_f(v); }
    __syncthreads();
    float* mod = (float*)(a.ws + WS_MOD);
    for (int it = first; it < limit; it += stride) {
        const int l = it / 144, n0 = (it % 144) * 64;
        const float* W = a.in[I_ADAW] + (size_t)l * 1024 * 9216 + n0 + lane;
        float a0 = 0.f, a1 = 0.f, a2 = 0.f;
        const int kb = wave * 128;
#pragma unroll 16
        for (int k = 0; k < 128; ++k) { const float wv = __builtin_nontemporal_load(&W[(size_t)(kb + k) * 9216]); a0 += sv[kb + k] * wv; a1 += sv[1024 + kb + k] * wv; a2 += sv[2048 + kb + k] * wv; }
        red[(wave * 3 + 0) * 64 + lane] = a0; red[(wave * 3 + 1) * 64 + lane] = a1; red[(wave * 3 + 2) * 64 + lane] = a2;
        __syncthreads();
        if (tid < 192) { const int g = tid >> 6, c = tid & 63; float sm = a.in[I_ADAB][l * 9216 + n0 + c];
#pragma unroll
            for (int w = 0; w < 8; ++w) sm += red[(w * 3 + g) * 64 + c];
            mod[(size_t)(l * 3 + g) * 9216 + n0 + c] = sm; }
        __syncthreads();
    }
}

__device__ __forceinline__ void convert_weights(const Args& a, LAS unsigned char* lds, const int group, const int first, const int step, const int end, const int gw, const int NGW) {
    const int lane = threadIdx.x & 63, wave = threadIdx.x >> 6;
    unsigned char* ws = a.ws;
    LAS float* scr = (LAS float*)(lds + wave * 16384);
    constexpr int I_FI = 16 * 176, I_FO = 44 * 32, I_RI = 16 * 80, I_RO = 20 * 32, I_GI = 16 * 97, I_GO = 16 * 32, I_GT = 8;
    const int mi0 = (group == 0) ? 0 : group + 1, nmi = (group == 0) ? 2 : 1;
    const int n_ri = (group == 0) ? I_RI : 0, n_ro = (group == 0) ? I_RO : 0, n_gt = (group == 0) ? 40 * I_GT : 0;
    const int n_gi = (group == 1) ? I_GI : 0, n_go = (group == 1) ? I_GO : 0;
    const int nitems = nmi * (I_FI + I_FO) + n_ri + n_ro + n_gi + n_go + n_gt;
    const int stop = end < nitems ? end : nitems;
    for (int it = first; it < stop; it += step) {
        int r = it;
        if (r < nmi * I_FI) { const int mi = mi0 + r / I_FI; r %= I_FI; const int kb = r / 176, n0 = (r % 176) * 32;
            const int drow = (n0 < DFF) ? (n0 / 128) * 256 + (n0 % 128) : ((n0 - DFF) / 128) * 256 + 128 + ((n0 - DFF) % 128);
            transpose_item(a.in[I_FWI] + (size_t)mi * 1024 * 5632, 5632, kb * 64, n0, (bf16*)(ws + WS_WFI) + ((size_t)mi * 5632 + drow) * 1024, 1024, scr, lane); continue; }
        r -= nmi * I_FI;
        if (r < nmi * I_FO) { const int mi = mi0 + r / I_FO; r %= I_FO; const int kb = r / 32, n0 = (r % 32) * 32;
            transpose_item(a.in[I_FWO] + (size_t)mi * 2816 * 1024, 1024, kb * 64, n0, (bf16*)(ws + WS_WFO) + ((size_t)mi * 1024 + n0) * 2816, 2816, scr, lane); continue; }
        r -= nmi * I_FO;
        if (r < n_ri) { const int kb = r / 80, n0 = (r % 80) * 32;
            transpose_item(a.in[I_RWI], 2560, kb * 64, n0, (bf16*)(ws + WS_WRI) + (size_t)n0 * 1024, 1024, scr, lane); continue; }
        r -= n_ri;
        if (r < n_ro) { const int kb = r / 32, n0 = (r % 32) * 32;
            transpose_item(a.in[I_RWO], 1024, kb * 64, n0, (bf16*)(ws + WS_WRO) + (size_t)n0 * 1280, 1280, scr, lane); continue; }
        r -= n_ro;
        if (r < n_gi) { const int kb = r / 97, n0 = (r % 97) * 32;
            transpose_item(a.in[I_GWI], GLA_N, kb * 64, n0, (bf16*)(ws + WS_WGI) + (size_t)n0 * 1024, 1024, scr, lane); continue; }
        r -= n_gi;
        if (r < n_go) { const int kb = r / 32, n0 = (r % 32) * 32;
            transpose_item(a.in[I_GWO], 1024, kb * 64, n0, (bf16*)(ws + WS_WGO) + (size_t)n0 * 1024, 1024, scr, lane); continue; }
        r -= n_go;
        { const int mi = r / I_GT; r %= I_GT; const int kb = r / 4, n0 = (r % 4) * 32;
          const int which = mi / 20, dn = mi % 20;
          const float* src = (which ? a.in[I_RWIG] : a.in[I_RWA]) + (size_t)dn * 128 * 128;
          transpose_item(src, 128, kb * 64, n0, (bf16*)(ws + WS_WGT) + ((size_t)dn * 256 + which * 128 + n0) * 128, 128, scr, lane); }
    }
    if (group == 1) {
        v4u* z = (v4u*)((bf16*)(ws + WS_WGI) + (size_t)GLA_N * 1024);
        const int nz = (GLA_NP - GLA_N) * 1024 * 2 / 16;
        for (int i = gw * 64 + lane; i < nz; i += NGW * 64) z[i] = (v4u){0u, 0u, 0u, 0u};
    }
}

__device__ __forceinline__ void phase_prep(const Args& a, LAS unsigned char* lds) {
    const int tid = threadIdx.x, lane = tid & 63, wave = tid >> 6;
    unsigned char* ws = a.ws;
    ada_items(a, lds, (int)blockIdx.x, (int)gridDim.x, (gridDim.x == 256) ? 144 : 288);
    __syncthreads();
    {
        const int gw = blockIdx.x * 8 + wave, NGW = gridDim.x * 8;
        if (gridDim.x == 256) {
            constexpr int N0 = 2 * (16 * 176) + 2 * (44 * 32) + 16 * 80 + 20 * 32 + 40 * 8, WTOT = 144 * 73 + 112 * 100;
            const int b = blockIdx.x;
            const int cw0 = (b < 144) ? 73 * b : 144 * 73 + 100 * (b - 144), cw1 = (b + 1 <= 144) ? 73 * (b + 1) : 144 * 73 + 100 * (b + 1 - 144);
            const int st = (int)(((long)N0 * cw0) / WTOT), en = (int)(((long)N0 * cw1) / WTOT);
            convert_weights(a, lds, 0, st + wave, 8, en, gw, NGW);
        } else {
            convert_weights(a, lds, 0, gw, NGW, 0x7fffffff, gw, NGW); convert_weights(a, lds, 1, gw, NGW, 0x7fffffff, gw, NGW); convert_weights(a, lds, 2, gw, NGW, 0x7fffffff, gw, NGW);
        }
    }
}

__device__ __forceinline__ void phase_combine(const Args& a, int first, int fin, int lg, int jg, float coef, int ln, int jn) {
    const int tid = threadIdx.x, lane = tid & 63, wave = tid >> 6;
    const int gw = blockIdx.x * 8 + wave, NGW = gridDim.x * 8;
    float* X = a.out; const float* mod = (const float*)(a.ws + WS_MOD); const bf16* P = (const bf16*)(a.ws + WS_P); bf16* XN = (bf16*)(a.ws + WS_XN);
    const bool aff = (gridDim.x == 256);
    const int affm0 = 2048 * ((blockIdx.x & 7) >> 1) + 32 * ((blockIdx.x & 1) * 32 + (blockIdx.x >> 3)) + 4 * wave;
    for (int m0 = aff ? affm0 : gw * 4; m0 < TOK; m0 += aff ? TOK : NGW * 4) {
        const int g = (m0 < NPROMPT) ? 0 : 1 + ((m0 - NPROMPT) >> 11);
        f32x4 cg[4], gs[4], sh[4];
#pragma unroll
        for (int j = 0; j < 4; ++j) {
            cg[j] = first ? (f32x4){0.f, 0.f, 0.f, 0.f} : coef * ((const f32x4*)(mod + (size_t)((lg * 3 + g) * 9 + 3 * jg + 2) * DM))[lane + 64 * j];
            if (fin) { gs[j] = ((const f32x4*)a.in[I_FNORM])[lane + 64 * j]; sh[j] = (f32x4){0.f, 0.f, 0.f, 0.f}; }
            else { gs[j] = ((const f32x4*)(a.in[I_NORMG] + (size_t)(ln * 3 + jn) * DM))[lane + 64 * j] * (1.0f + ((const f32x4*)(mod + (size_t)((ln * 3 + g) * 9 + 3 * jn + 1) * DM))[lane + 64 * j]);
                   sh[j] = ((const f32x4*)(mod + (size_t)((ln * 3 + g) * 9 + 3 * jn) * DM))[lane + 64 * j]; }
        }
#pragma unroll 2
        for (int r = 0; r < 4; ++r) {
            const int m = m0 + r;
            const float* xs = first ? ((m < NPROMPT) ? a.in[I_XP] + (size_t)m * DM : a.in[I_XS] + (size_t)(m - NPROMPT) * DM) : X + (size_t)m * DM;
            f32x4 v[4];
#pragma unroll
            for (int j = 0; j < 4; ++j) v[j] = first ? __builtin_nontemporal_load(&((const f32x4*)xs)[lane + 64 * j]) : ((const f32x4*)xs)[lane + 64 * j];
            if (!first) {
                const v2u* p0 = (const v2u*)(P + (size_t)m * DM); const v2u* p1 = (const v2u*)(P + (size_t)TOK * DM + (size_t)m * DM);
#pragma unroll
                for (int j = 0; j < 4; ++j) { const v2u a0 = p0[lane + 64 * j], a1 = p1[lane + 64 * j];
                    const f32x4 ps = (f32x4){bflo(a0.x) + bflo(a1.x), bfhi(a0.x) + bfhi(a1.x), bflo(a0.y) + bflo(a1.y), bfhi(a0.y) + bfhi(a1.y)};
                    v[j] += cg[j] * ps; }
            }
            float ss = 0.f;
#pragma unroll
            for (int j = 0; j < 4; ++j) ss += (v[j][0] * v[j][0] + v[j][1] * v[j][1]) + (v[j][2] * v[j][2] + v[j][3] * v[j][3]);
            const float rstd = 1.0f / sqrtf(wave_sum(ss) * (1.0f / DM) + EPS);
            if (fin) {
#pragma unroll
                for (int j = 0; j < 4; ++j) ((f32x4*)(X + (size_t)m * DM))[lane + 64 * j] = v[j] * rstd * gs[j];
            } else {
#pragma unroll
                for (int j = 0; j < 4; ++j) {
                    ((f32x4*)(X + (size_t)m * DM))[lane + 64 * j] = v[j];
                    const f32x4 y = (v[j] * rstd) * gs[j] + sh[j];
                    v2u w; w.x = cvt_pk_bf16(y[0], y[1]); w.y = cvt_pk_bf16(y[2], y[3]);
                    ((v2u*)(XN + (size_t)m * DM))[lane + 64 * j] = w;
                }
            }
        }
    }
}

__device__ __forceinline__ void phase_rg(const Args& a, LAS unsigned char* lds) {
    const int tid = threadIdx.x, lane = tid & 63, w = __builtin_amdgcn_readfirstlane(tid >> 6), l15 = lane & 15, lq = lane >> 4;
    unsigned char* ws = a.ws;
    const bf16* XBR = (const bf16*)(ws + WS_P);
    const bf16* GG = (const bf16*)(ws + WS_MIX);
    bf16* Y2 = (bf16*)(ws + WS_HID);
    bf16* PG = (bf16*)(ws + WS_PG);
    const bf16* WG = (const bf16*)(ws + WS_WGT);
    f32x2* SEG = (f32x2*)(ws + WS_SEG);
    LAS float* XCF = (LAS float*)lds;
    LAS unsigned short* XA = (LAS unsigned short*)(lds + 32768);
    LAS f32x2* AU = (LAS f32x2*)(lds + 50176);
    const int cc = tid & 127, tg = w >> 1;
    const int nitems = 320 + 640;
    const bool deal = (gridDim.x == 256);
    for (int kk = 0;; ++kk) {
        int it;
        if (deal) { const int b = blockIdx.x; if (kk > 3) break;
            if (kk == 0) it = b; else if (kk == 1) it = (b < 64) ? 256 + b : 320 + (b - 64); else if (kk == 2) it = 320 + 192 + b; else { if (b < 64) break; it = 320 + 448 + (b - 64); } }
        else { it = blockIdx.x + kk * gridDim.x; if (it >= nitems) break; }
        int s, r, pseg = 0, sb = 0;
        if (it < 320) { s = it / 20; r = it % 20; }
        else { const int q = it - 320; sb = q / 320; const int q2 = q % 320; pseg = q2 / 20; r = q2 % 20; s = 16 + sb; }
        const bool fix = (s >= 16 && pseg >= 1);
        const int n = r >> 1, d = r & 1;
        const int T = (s < 16) ? 256 : 2048, mb = (s < 16) ? s * 256 : NPROMPT + (s - 16) * 2048;
        const int ti0 = (s < 16) ? 0 : 2 * pseg, ti1 = (s < 16) ? 4 : 2 * pseg + 2;
        bf16x8 bfr[2][4];
        { const bf16* wg = WG + (size_t)((d * 10 + n) * 256) * 128;
#pragma unroll
          for (int f = 0; f < 2; ++f)
#pragma unroll
              for (int ks = 0; ks < 4; ++ks) bfr[f][ks] = *(const bf16x8*)(wg + (size_t)(f * 128 + 16 * w + l15) * 128 + 32 * ks + 8 * lq); }
        const int ch = 16 * w + l15, C = n * 128 + ch;
        const float ba = a.in[I_RBA][d * DRNN + C], bi = a.in[I_RBI][d * DRNN + C];
        float sp8; { const float nl = -a.in[I_RLAM][d * DRNN + C]; sp8 = 8.0f * (fmaxf(nl, 0.f) + log1pf(__expf(-fabsf(nl)))); }
        const int Cc = n * 128 + cc;
        const float w0 = a.in[I_RCW][Cc], w1 = a.in[I_RCW][DRNN + Cc], w2 = a.in[I_RCW][2 * DRNN + Cc], w3 = a.in[I_RCW][3 * DRNN + Cc], cb = a.in[I_RCB][Cc];
        float h = 0.f, pprod = 1.f;
        if (tid < 128 && s >= 16 && pseg == 0) h = a.in[I_SRG][((s - 16) * 2 + d) * DRNN + n * 128 + tid];
        unsigned xr[19]; unsigned ggp[8]; unsigned xm = 0u;
#pragma unroll
        for (int p = 0; p < 8; ++p) ggp[p] = 0u;
#define RG_LOAD(ti_) do { const int t0_ = d ? T - 64 * ((ti_) + 1) : 64 * (ti_); const int ts_ = t0_ + 16 * tg - 1; \
        const bf16* xp_ = XBR + (long)(mb + ts_) * DRNN + Cc; xm = 0u; \
        _Pragma("unroll") for (int i = 0; i < 19; ++i) { xr[i] = (unsigned)xp_[i * DRNN]; xm |= ((unsigned)(ts_ + i) < (unsigned)T) ? (1u << i) : 0u; } \
        const bf16* gp_ = GG + (size_t)(mb + t0_ + w) * DRNN + n * 128 + lane * 2; \
        _Pragma("unroll") for (int p = 0; p < 8; ++p) ggp[p] = *(const unsigned*)(gp_ + (size_t)(8 * p) * DRNN); } while (0)
        RG_LOAD(ti0);
        for (int ti = ti0; ti < ti1; ++ti) {
            const int t0 = d ? T - 64 * (ti + 1) : 64 * ti;
            float xv[19];
#pragma unroll
            for (int i = 0; i < 19; ++i) xv[i] = ((xm >> i) & 1u) ? __uint_as_float(xr[i] << 16) : 0.f;
#pragma unroll
            for (int i = 0; i < 16; ++i) { const float xc = cb + w0 * xv[i] + w1 * xv[i + 1] + w2 * xv[i + 2] + w3 * xv[i + 3];
                const int tl = 16 * tg + i; XCF[tl * 128 + cc] = xc; XA[tl * 136 + cc] = (unsigned short)(cvt_pk_bf16(xc, 0.f) & 0xffffu); }
            unsigned ggc[8];
#pragma unroll
            for (int p = 0; p < 8; ++p) ggc[p] = ggp[p];
            LDS_BAR();
            if (ti + 1 < ti1) RG_LOAD(ti + 1);
            f32x4 accA[4], accI[4]; float xcv[16];
#pragma unroll
            for (int mf = 0; mf < 4; ++mf) { accA[mf] = (f32x4){0.f, 0.f, 0.f, 0.f}; accI[mf] = (f32x4){0.f, 0.f, 0.f, 0.f}; }
#pragma unroll
            for (int e = 0; e < 16; ++e) xcv[e] = XCF[(16 * (e >> 2) + 4 * lq + (e & 3)) * 128 + ch];
#pragma unroll
            for (int ks = 0; ks < 4; ++ks)
#pragma unroll
                for (int mf = 0; mf < 4; ++mf) { const bf16x8 af = *(const LAS bf16x8*)(XA + (16 * mf + l15) * 136 + 32 * ks + 8 * lq);
                    accA[mf] = __builtin_amdgcn_mfma_f32_16x16x32_bf16(af, bfr[0][ks], accA[mf], 0, 0, 0);
                    accI[mf] = __builtin_amdgcn_mfma_f32_16x16x32_bf16(af, bfr[1][ks], accI[mf], 0, 0, 0); }
#pragma unroll
            for (int mf = 0; mf < 4; ++mf)
#pragma unroll
                for (int rg = 0; rg < 4; ++rg) { const int tl = 16 * mf + 4 * lq + rg;
                    const float rr = fast_sigmoid(accA[mf][rg] + ba), gi = fast_sigmoid(accI[mf][rg] + bi);
                    const float la = -sp8 * rr; const float av = __expf(la); const float uu = __builtin_amdgcn_sqrtf(fmaxf(1.0f - av * av, 0.f)) * gi * xcv[mf * 4 + rg];
                    AU[tl * 128 + ch] = (f32x2){av, uu}; }
            LDS_BAR();
            if (tid < 128) {
#pragma unroll 1
                for (int i0 = 0; i0 < 64; i0 += 8) {
                    f32x2 au[8];
#pragma unroll
                    for (int k = 0; k < 8; ++k) { const int tl = d ? 63 - (i0 + k) : i0 + k; au[k] = AU[tl * 128 + tid]; }
#pragma unroll
                    for (int k = 0; k < 8; ++k) { h = au[k].x * h + au[k].y; pprod *= au[k].x; au[k] = (f32x2){h, pprod}; }
#pragma unroll
                    for (int k = 0; k < 8; ++k) { const int tl = d ? 63 - (i0 + k) : i0 + k; AU[tl * 128 + tid] = au[k]; }
                }
            }
            LDS_BAR();
            f32x4 hp[8];
#pragma unroll
            for (int p = 0; p < 8; ++p) hp[p] = *(const LAS f32x4*)(AU + (8 * p + w) * 128 + lane * 2);
#pragma unroll
            for (int p = 0; p < 8; ++p) { const int tl = 8 * p + w, cp = lane * 2; const float g0 = bflo(ggc[p]), g1 = bfhi(ggc[p]);
                *(unsigned*)(Y2 + (size_t)(mb + t0 + tl) * (2 * DRNN) + d * DRNN + n * 128 + cp) = cvt_pk_bf16(hp[p][0] * g0, hp[p][2] * g1);
                if (fix) *(unsigned*)(PG + (size_t)(mb - NPROMPT + t0 + tl) * (2 * DRNN) + d * DRNN + n * 128 + cp) = cvt_pk_bf16(hp[p][1] * g0, hp[p][3] * g1); }
            LDS_BAR();
        }
#undef RG_LOAD
        if (tid < 128) {
            if (s < 16) a.out[OUT_RG + (size_t)(s * 2 + d) * DRNN + n * 128 + tid] = h;
            else SEG[(size_t)((sb * 16 + pseg) * 2 + d) * DRNN + n * 128 + tid] = (f32x2){pprod, h};
        }
    }
}

__device__ __forceinline__ void phase_rg_fix(const Args& a) {
    const int tid = threadIdx.x;
    unsigned char* ws = a.ws;
    bf16* Y2 = (bf16*)(ws + WS_HID); const bf16* PG = (const bf16*)(ws + WS_PG); const f32x2* SEG = (const f32x2*)(ws + WS_SEG);
    const int cp = (tid & 63) * 2, r8 = tid >> 6;
    for (int it = blockIdx.x; it < 640; it += gridDim.x) {
        const int n = it % 10, q = it / 10;
        const bool smp = q >= 32;
        const int sb = smp ? ((q - 32) >> 4) : 0, ts = smp ? ((q - 32) & 15) : 0;
        const int mb = smp ? NPROMPT + sb * 2048 + ts * 128 : q * 128;
        const int psf = smp ? ts : 0, psb = smp ? 15 - ts : 0;
        float hf0 = 0.f, hf1 = 0.f, hb0 = 0.f, hb1 = 0.f;
        if (smp) {
            f32x4 sf[15], sbk[15];
#pragma unroll
            for (int j = 0; j < 15; ++j) {
                sf[j]  = (j < psf) ? *(const f32x4*)(SEG + (size_t)((sb * 16 + j) * 2 + 0) * DRNN + n * 128 + cp) : (f32x4){1.f, 0.f, 1.f, 0.f};
                sbk[j] = (j < psb) ? *(const f32x4*)(SEG + (size_t)((sb * 16 + j) * 2 + 1) * DRNN + n * 128 + cp) : (f32x4){1.f, 0.f, 1.f, 0.f}; }
            hf0 = sf[0][1]; hf1 = sf[0][3]; hb0 = sbk[0][1]; hb1 = sbk[0][3];
#pragma unroll
            for (int j = 1; j < 15; ++j) { hf0 = sf[j][0] * hf0 + sf[j][1]; hf1 = sf[j][2] * hf1 + sf[j][3]; hb0 = sbk[j][0] * hb0 + sbk[j][1]; hb1 = sbk[j][2] * hb1 + sbk[j][3]; }
            if (psf == 0) { hf0 = 0.f; hf1 = 0.f; }
            if (psb == 0) { hb0 = 0.f; hb1 = 0.f; }
        }
        unsigned yf[16], yb[16], pf[16], pb[16];
#pragma unroll
        for (int i = 0; i < 16; ++i) { const size_t row = (size_t)(mb + 8 * i + r8);
            yf[i] = *(const unsigned*)(Y2 + row * (2 * DRNN) + n * 128 + cp); yb[i] = *(const unsigned*)(Y2 + row * (2 * DRNN) + DRNN + n * 128 + cp);
            pf[i] = (smp && psf >= 1) ? *(const unsigned*)(PG + (row - NPROMPT) * (2 * DRNN) + n * 128 + cp) : 0u;
            pb[i] = (smp && psb >= 1) ? *(const unsigned*)(PG + (row - NPROMPT) * (2 * DRNN) + DRNN + n * 128 + cp) : 0u; }
#pragma unroll
        for (int i = 0; i < 16; ++i) { const size_t row = (size_t)(mb + 8 * i + r8);
            const float s0 = (bflo(yf[i]) + bflo(pf[i]) * hf0) + (bflo(yb[i]) + bflo(pb[i]) * hb0), s1 = (bfhi(yf[i]) + bfhi(pf[i]) * hf1) + (bfhi(yb[i]) + bfhi(pb[i]) * hb1);
            *(unsigned*)(Y2 + row * (2 * DRNN) + n * 128 + cp) = cvt_pk_bf16(s0, s1); }
    }
}

#define GLA_ROW(tp_) (rbase + ((tp_) & rmask) * rmul + ((tp_) >> rshift))
__device__ __forceinline__ void phase_gla_pre(const Args& a, LAS unsigned char* lds) {
    const int tid = threadIdx.x, lane = tid & 63, w = tid >> 6, l15 = lane & 15, lq = lane >> 4;
    unsigned char* ws = a.ws;
    const bf16* PROJ = (const bf16*)(ws + WS_MIX); const float* Z = (const float*)(ws + WS_Z);
    v4u* QF = (v4u*)(ws + WS_QF); v4u* KF = (v4u*)(ws + WS_KF); float* DEC = (float*)(ws + WS_DEC); v4u* VF = (v4u*)(ws + WS_VF); v4u* PF = (v4u*)(ws + WS_PF);
    LAS unsigned short* QS = (LAS unsigned short*)lds;
    LAS unsigned short* KS = (LAS unsigned short*)(lds + 8704);
    LAS unsigned short* KT = (LAS unsigned short*)(lds + 17408);
    LAS unsigned short* PS = (LAS unsigned short*)(lds + 27648);
    LAS float* ZS = (LAS float*)(lds + 30208);
    LAS float* CS = (LAS float*)(lds + 32256);
    LAS unsigned short* VT = (LAS unsigned short*)(lds + 34304);
    const int dk = tid & 127, ig = tid >> 7;
    const int G = gridDim.x;
    const bool hoist = (G & 7) == 0;
    float w2r[16]; float bg = 0.f;
#define GP_W(g_) do { const int hh_ = (g_) & 3, d_ = ((g_) >> 2) & 1; \
        _Pragma("unroll") for (int q = 0; q < 16; ++q) w2r[q] = a.in[I_GW2][(size_t)(d_ * 16 + q) * 512 + hh_ * 128 + dk]; \
        bg = a.in[I_GBG][d_ * 512 + hh_ * 128 + dk]; } while (0)
    unsigned nq[8], nk[8]; float nz = 0.f; v4u nv0 = (v4u){0u, 0u, 0u, 0u}, nv1 = nv0;
#define GP_LOAD(g_) do { const int hh_ = (g_) & 3, d_ = ((g_) >> 2) & 1, cid_ = (g_) >> 3; \
        const int s_ = (cid_ < 128) ? (cid_ >> 3) : 16 + ((cid_ - 128) >> 6), cf_ = (cid_ < 128) ? (cid_ & 7) : ((cid_ - 128) & 63); \
        const int rbase = (s_ < 16) ? s_ * 256 : NPROMPT + (s_ - 16) * 2048, rmask = (s_ < 16) ? 0x7fffffff : 31, rmul = (s_ < 16) ? 1 : 64, rshift = (s_ < 16) ? 30 : 5; \
        _Pragma("unroll") for (int ii = 0; ii < 8; ++ii) { const int i = 8 * ig + ii; const int m = GLA_ROW(32 * cf_ + (d_ ? 31 - i : i)); \
            nq[ii] = PROJ[(size_t)m * PROJ_LD + hh_ * 128 + dk]; nk[ii] = PROJ[(size_t)m * PROJ_LD + 512 + hh_ * 128 + dk]; } \
        { const int iz = tid >> 4; const int mz = GLA_ROW(32 * cf_ + (d_ ? 31 - iz : iz)); nz = Z[(size_t)mz * 32 + d_ * 16 + (tid & 15)]; \
          const int i = tid & 31, cg = tid >> 5; const int m = GLA_ROW(32 * cf_ + (d_ ? 31 - i : i)); \
          const v4u* vp = (const v4u*)(PROJ + (size_t)m * PROJ_LD + 1024 + hh_ * 256 + cg * 16); nv0 = vp[0]; nv1 = vp[1]; } } while (0)
    if ((int)blockIdx.x < 2048) { GP_LOAD((int)blockIdx.x); if (hoist) GP_W((int)blockIdx.x); }
    for (int g = blockIdx.x; g < 2048; g += G) {
        const int hh = g & 3, d = (g >> 2) & 1, cid = g >> 3;
        if (!hoist) GP_W(g);
        unsigned pq[8], pk_[8];
#pragma unroll
        for (int ii = 0; ii < 8; ++ii) { pq[ii] = nq[ii]; pk_[ii] = nk[ii]; }
        { const int iz = tid >> 4; const int i = tid & 31, cg = tid >> 5;
          const v4u v0 = nv0, v1 = nv1;
          ZS[iz * 16 + (tid & 15)] = nz;
          LAS unsigned short* vt = VT + (cg * 16) * 40 + i;
          vt[0 * 40] = (unsigned short)(v0.x & 0xffffu); vt[1 * 40] = (unsigned short)(v0.x >> 16); vt[2 * 40] = (unsigned short)(v0.y & 0xffffu); vt[3 * 40] = (unsigned short)(v0.y >> 16);
          vt[4 * 40] = (unsigned short)(v0.z & 0xffffu); vt[5 * 40] = (unsigned short)(v0.z >> 16); vt[6 * 40] = (unsigned short)(v0.w & 0xffffu); vt[7 * 40] = (unsigned short)(v0.w >> 16);
          vt[8 * 40] = (unsigned short)(v1.x & 0xffffu); vt[9 * 40] = (unsigned short)(v1.x >> 16); vt[10 * 40] = (unsigned short)(v1.y & 0xffffu); vt[11 * 40] = (unsigned short)(v1.y >> 16);
          vt[12 * 40] = (unsigned short)(v1.z & 0xffffu); vt[13 * 40] = (unsigned short)(v1.z >> 16); vt[14 * 40] = (unsigned short)(v1.w & 0xffffu); vt[15 * 40] = (unsigned short)(v1.w >> 16); }
        if (g + G < 2048) GP_LOAD(g + G);
        LDS_BAR();
        float cum[8]; float run = 0.f;
#pragma unroll
        for (int ii = 0; ii < 8; ++ii) { const int i = 8 * ig + ii; float zz = bg;
#pragma unroll
            for (int q4 = 0; q4 < 4; ++q4) { const f32x4 zv = *(const LAS f32x4*)(ZS + i * 16 + 4 * q4);
                zz += zv[0] * w2r[4 * q4] + zv[1] * w2r[4 * q4 + 1] + zv[2] * w2r[4 * q4 + 2] + zv[3] * w2r[4 * q4 + 3]; }
            const float lg = (fminf(zz, 0.f) - __logf(1.0f + __expf(-fabsf(zz)))) * 0.0625f;
            run += lg; cum[ii] = run; }
        CS[ig * 128 + dk] = run;
        LDS_BAR();
        { float pre = 0.f, tot = 0.f;
#pragma unroll
          for (int g2 = 0; g2 < 4; ++g2) { const float v = CS[g2 * 128 + dk]; tot += v; if (g2 < ig) pre += v; }
          float k2[8];
#pragma unroll
          for (int ii = 0; ii < 8; ++ii) { const int i = 8 * ig + ii; const float b = pre + cum[ii];
              const float qv = __uint_as_float(pq[ii] << 16), kv = __uint_as_float(pk_[ii] << 16);
              QS[i * 136 + dk] = (unsigned short)(cvt_pk_bf16(qv * __expf(b), 0.f) & 0xffffu);
              KS[i * 136 + dk] = (unsigned short)(cvt_pk_bf16(kv * __expf(-b), 0.f) & 0xffffu);
              k2[ii] = kv * __expf(tot - b); }
          *(LAS v4u*)(KT + dk * 40 + 8 * ig) = (v4u){cvt_pk_bf16(k2[0], k2[1]), cvt_pk_bf16(k2[2], k2[3]), cvt_pk_bf16(k2[4], k2[5]), cvt_pk_bf16(k2[6], k2[7])};
          if (ig == 0) DEC[(size_t)g * 128 + dk] = __expf(tot); }
        LDS_BAR();
        if (w < 4) {
            const int mi2 = w >> 1, nj = w & 1; f32x4 sc = (f32x4){0.f, 0.f, 0.f, 0.f};
#pragma unroll
            for (int ks = 0; ks < 4; ++ks) { const bf16x8 aq = *(const LAS bf16x8*)(QS + (16 * mi2 + l15) * 136 + 32 * ks + 8 * lq);
                const bf16x8 bk = *(const LAS bf16x8*)(KS + (16 * nj + l15) * 136 + 32 * ks + 8 * lq);
                sc = __builtin_amdgcn_mfma_f32_16x16x32_bf16(aq, bk, sc, 0, 0, 0); }
#pragma unroll
            for (int rg = 0; rg < 4; ++rg) { const int i = 16 * mi2 + 4 * lq + rg, j = 16 * nj + l15;
                PS[i * 40 + j] = (unsigned short)(cvt_pk_bf16((j <= i) ? sc[rg] : 0.f, 0.f) & 0xffffu); }
        }
        { const int mi = w >> 2, ks = w & 3;
          const v2u lo = *(const LAS v2u*)(QS + (16 * mi + l15) * 136 + 32 * ks + 4 * lq), hi = *(const LAS v2u*)(QS + (16 * mi + l15) * 136 + 32 * ks + 16 + 4 * lq);
          QF[((size_t)g * 8 + w) * 64 + lane] = (v4u){lo.x, lo.y, hi.x, hi.y};
          KF[((size_t)g * 8 + w) * 64 + lane] = *(const LAS v4u*)(KT + (16 * w + l15) * 40 + 8 * lq);
          if (d == 0) {
#pragma unroll
              for (int h2 = 0; h2 < 2; ++h2) { const int nb = 2 * w + h2;
                  VF[((size_t)cid * 64 + hh * 16 + nb) * 64 + lane] = *(const LAS v4u*)(VT + (16 * nb + l15) * 40 + 8 * lq); } } }
        LDS_BAR();
        if (w < 2) PF[((size_t)g * 2 + w) * 64 + lane] = *(const LAS v4u*)(PS + (16 * w + l15) * 40 + 8 * lq);
        LDS_BAR();
    }
#undef GP_W
#undef GP_LOAD
}

__device__ __forceinline__ unsigned rot16(unsigned x) { return (x >> 16) | (x << 16); }
__device__ __forceinline__ void phase_gla_scan(const Args& a, LAS unsigned char* lds) {
    const int tid = threadIdx.x, lane = tid & 63, w = tid >> 6, l15 = lane & 15, lq = lane >> 4;
    unsigned char* ws = a.ws;
    const v4u* QF = (const v4u*)(ws + WS_QF); const v4u* KF = (const v4u*)(ws + WS_KF); const float* DEC = (const float*)(ws + WS_DEC); const v4u* VF = (const v4u*)(ws + WS_VF); const v4u* PF = (const v4u*)(ws + WS_PF);
    const int G = gridDim.x, b = blockIdx.x;
    LAS v4u* RING = (LAS v4u*)lds;
    for (int k = 0;; ++k) {
        const int it = (k & 1) ? k * G + (G - 1 - b) : k * G + b;
        if (it >= 64 + 256) break;
        const bool lng = it < 64; const int r = lng ? it : it - 64;
        const int hh = lng ? ((r >> 2) & 3) : ((r >> 1) & 3), d = lng ? ((r >> 4) & 1) : ((r >> 3) & 1), sq = lng ? (r >> 5) : (r >> 4);
        const bool act = lng ? (w < 4) : true;
        const int sl = lng ? (r & 3) * 4 + (w & 3) : (r & 1) * 8 + w, s = lng ? 16 + sq : sq;
        const int nch = lng ? 64 : 8, cid0 = lng ? 128 + sq * 64 : sq * 8;
        const int rbase = (s < 16) ? s * 256 : NPROMPT + (s - 16) * 2048, rmask = (s < 16) ? 0x7fffffff : 31, rmul = (s < 16) ? 1 : 64, rshift = (s < 16) ? 30 : 5;
        bf16* O = (bf16*)(ws + WS_P) + (size_t)d * TOK * DM + hh * 256 + 16 * sl + l15;
        const int vlane = d ? (l15 + 16 * (3 - lq)) : lane;
        bf16* op[2][4];
#pragma unroll
        for (int mi = 0; mi < 2; ++mi)
#pragma unroll
            for (int rg = 0; rg < 4; ++rg) { const int i = 16 * mi + 4 * lq + rg; const int ip = d ? 31 - i : i; op[mi][rg] = O + (size_t)(rbase + ip * ((s < 16) ? 1 : 64)) * DM; }
        const size_t cstride = (size_t)((s < 16) ? 32 : 1) * DM;
        f32x4 sacc[8];
#pragma unroll
        for (int f = 0; f < 8; ++f) {
            if (lng) { const float* sp = a.in[I_SGLA] + (size_t)((sq * 2 + d) * 4 + hh) * 32768 + (size_t)(16 * f + 4 * lq) * 256 + 16 * sl + l15;
                sacc[f] = (f32x4){sp[0], sp[256], sp[512], sp[768]}; }
            else sacc[f] = (f32x4){0.f, 0.f, 0.f, 0.f};
        }
        v4u qn[2][8], vn[2], kst[2], dsx[2], pn[2][2];
        dsx[0] = (v4u){0u, 0u, 0u, 0u}; dsx[1] = (v4u){0u, 0u, 0u, 0u};
#pragma unroll
        for (int u = 0; u < 2; ++u) { vn[u] = (v4u){0u, 0u, 0u, 0u}; pn[u][0] = vn[u]; pn[u][1] = vn[u];
#pragma unroll
            for (int q = 0; q < 8; ++q) qn[u][q] = vn[u]; }
#define GS_LOAD(u_, c_) do { const int cid_ = cid0 + (d ? nch - 1 - (c_) : (c_)); const size_t g_ = ((size_t)cid_ * 2 + d) * 4 + hh; \
        kst[u_] = KF[g_ * 512 + tid]; if (tid < 32) dsx[u_] = *(const v4u*)(DEC + g_ * 128 + 4 * tid); \
        if (act) { _Pragma("unroll") for (int q = 0; q < 8; ++q) qn[u_][q] = QF[(g_ * 8 + q) * 64 + lane]; \
        vn[u_] = VF[((size_t)cid_ * 64 + hh * 16 + sl) * 64 + vlane]; \
        pn[u_][0] = PF[(g_ * 2 + 0) * 64 + lane]; pn[u_][1] = PF[(g_ * 2 + 1) * 64 + lane]; } } while (0)
#define GS_STAGE(slot_, u_) do { RING[(slot_) * 544 + tid] = kst[u_]; if (tid < 32) RING[(slot_) * 544 + 512 + tid] = dsx[u_]; } while (0)
        GS_LOAD(0, 0); GS_LOAD(1, 1);
        GS_STAGE(0, 0);
        LDS_BAR();
        for (int c0 = 0; c0 < nch; c0 += 2) {
#pragma unroll
          for (int u = 0; u < 2; ++u) {
            const int c = c0 + u;
            const int cid = cid0 + (d ? nch - 1 - c : c); const int cf = cid - cid0;
            if (!act) { if (c + 2 < nch) GS_LOAD(u, c + 2); if (c + 1 < nch) GS_STAGE((c + 1) & 1, u ^ 1); LDS_BAR(); continue; }
            v4u qf[8]; f32x4 o[2];
#pragma unroll
            for (int q = 0; q < 8; ++q) qf[q] = qn[u][q];
            v4u vf = vn[u]; const v4u pf0 = pn[u][0], pf1 = pn[u][1];
            if (d) vf = (v4u){rot16(vf.w), rot16(vf.z), rot16(vf.y), rot16(vf.x)};
            const bf16x8 vb = __builtin_bit_cast(bf16x8, vf);
            if (c + 2 < nch) GS_LOAD(u, c + 2);
            o[0] = __builtin_amdgcn_mfma_f32_16x16x32_bf16(__builtin_bit_cast(bf16x8, pf0), vb, (f32x4){0.f, 0.f, 0.f, 0.f}, 0, 0, 0);
            o[1] = __builtin_amdgcn_mfma_f32_16x16x32_bf16(__builtin_bit_cast(bf16x8, pf1), vb, (f32x4){0.f, 0.f, 0.f, 0.f}, 0, 0, 0);
            const LAS v4u* slot = RING + (c & 1) * 544;
#pragma unroll
            for (int ks = 0; ks < 4; ++ks) {
                v4u sb; sb.x = cvt_pk_bf16(sacc[2 * ks][0], sacc[2 * ks][1]); sb.y = cvt_pk_bf16(sacc[2 * ks][2], sacc[2 * ks][3]);
                sb.z = cvt_pk_bf16(sacc[2 * ks + 1][0], sacc[2 * ks + 1][1]); sb.w = cvt_pk_bf16(sacc[2 * ks + 1][2], sacc[2 * ks + 1][3]);
                const bf16x8 sbv = __builtin_bit_cast(bf16x8, sb);
                o[0] = __builtin_amdgcn_mfma_f32_16x16x32_bf16(__builtin_bit_cast(bf16x8, qf[ks]), sbv, o[0], 0, 0, 0);
                o[1] = __builtin_amdgcn_mfma_f32_16x16x32_bf16(__builtin_bit_cast(bf16x8, qf[4 + ks]), sbv, o[1], 0, 0, 0);
            }
#pragma unroll
            for (int mi = 0; mi < 2; ++mi)
#pragma unroll
                for (int rg = 0; rg < 4; ++rg) op[mi][rg][(size_t)cf * cstride] = (bf16)(cvt_pk_bf16(o[mi][rg], 0.f) & 0xffffu);
#pragma unroll
            for (int f = 0; f < 8; ++f) { const v4u kfv = slot[f * 64 + lane]; const f32x4 dec = *(const LAS f32x4*)((const LAS float*)(slot + 512) + 16 * f + 4 * lq);
                sacc[f] = sacc[f] * dec; sacc[f] = __builtin_amdgcn_mfma_f32_16x16x32_bf16(__builtin_bit_cast(bf16x8, kfv), vb, sacc[f], 0, 0, 0); }
            if (c + 1 < nch) GS_STAGE((c + 1) & 1, u ^ 1);
            LDS_BAR();
          }
        }
#undef GS_LOAD
#undef GS_STAGE
        if (!lng) {
#pragma unroll
            for (int f = 0; f < 8; ++f) { float* dp = a.out + OUT_GLA + (size_t)((s * 2 + d) * 4 + hh) * 32768 + (size_t)(16 * f + 4 * lq) * 256 + 16 * sl + l15;
                dp[0] = sacc[f][0]; dp[256] = sacc[f][1]; dp[512] = sacc[f][2]; dp[768] = sacc[f][3]; }
        }
    }
}

__device__ __forceinline__ void phase_gla_norm(const Args& a) {
    const int tid = threadIdx.x, lane = tid & 63, wave = tid >> 6;
    const int gw = blockIdx.x * 8 + wave, NGW = gridDim.x * 8;
    const bf16* Of = (const bf16*)(a.ws + WS_P); const bf16* Ob = Of + (size_t)TOK * DM;
    const bf16* PROJ = (const bf16*)(a.ws + WS_MIX); bf16* AO = (bf16*)(a.ws + WS_XN);
    const bool aff = (gridDim.x == 256);
    const int affm0 = 2048 * ((blockIdx.x & 7) >> 1) + 32 * ((blockIdx.x & 1) * 32 + (blockIdx.x >> 3)) + 4 * wave;
    for (int m0 = aff ? affm0 : gw * 4; m0 < TOK; m0 += aff ? TOK : NGW * 4) {
        f32x4 gn[4];
#pragma unroll
        for (int j = 0; j < 4; ++j) gn[j] = ((const f32x4*)a.in[I_GNORM])[lane + 64 * j];
#pragma unroll 2
        for (int r = 0; r < 4; ++r) {
            const int m = m0 + r;
#pragma unroll
            for (int j = 0; j < 4; ++j) {
                const v2u of = ((const v2u*)(Of + (size_t)m * DM))[lane + 64 * j], ob = ((const v2u*)(Ob + (size_t)m * DM))[lane + 64 * j];
                const f32x4 v = (f32x4){bflo(of.x) + bflo(ob.x), bfhi(of.x) + bfhi(ob.x), bflo(of.y) + bflo(ob.y), bfhi(of.y) + bfhi(ob.y)};
                const float ss = wave_sum((v[0] * v[0] + v[1] * v[1]) + (v[2] * v[2] + v[3] * v[3]));
                const float rstd = 1.0f / sqrtf(ss * (1.0f / 256.0f) + EPS);
                const v2u sr = *(const v2u*)(PROJ + (size_t)m * PROJ_LD + 2048 + 256 * j + 4 * lane);
                v2u wv; wv.x = cvt_pk_bf16(v[0] * rstd * gn[j][0] * bflo(sr.x), v[1] * rstd * gn[j][1] * bfhi(sr.x));
                wv.y = cvt_pk_bf16(v[2] * rstd * gn[j][2] * bflo(sr.y), v[3] * rstd * gn[j][3] * bfhi(sr.y));
                ((v2u*)(AO + (size_t)m * DM))[lane + 64 * j] = wv;
            }
        }
    }
}

#define XB_TMO      128
#define XB_XCNT(j)  (256  + 64 * (j))
#define XB_XSUB(j)  (1280 + 64 * (j))
#define XB_XGEN(j)  (2304 + 64 * (j))
#define XB_TOP      3328
#define XB_TOPGEN   3392
#define XCD_BAR_WORDS 3456
#define XB_SPIN_CAP (1u << 18)
__device__ __forceinline__ unsigned xb_ld(unsigned* p)              { return __hip_atomic_load(p, __ATOMIC_RELAXED, __HIP_MEMORY_SCOPE_AGENT); }
__device__ __forceinline__ unsigned xb_add(unsigned* p, unsigned v) { return __hip_atomic_fetch_add(p, v, __ATOMIC_RELAXED, __HIP_MEMORY_SCOPE_AGENT); }
__device__ __forceinline__ unsigned xb_xcc_id() { return (unsigned)__builtin_amdgcn_s_getreg((3 << 11) | 20) & 0xFu; }
#define XB_SPIN(cond, bar) do { unsigned _sp = 0; while (cond) { __builtin_amdgcn_s_sleep(1); \
    if ((++_sp & 255u) == 0u) { if (xb_ld(&(bar)[XB_TMO])) break; if (_sp > XB_SPIN_CAP) { atomicAdd(&(bar)[XB_TMO], 1u); break; } } } } while (0)
struct XcdBarrier { unsigned* bar; unsigned x; volatile LAS unsigned* st; };
__device__ __forceinline__ XcdBarrier xcd_barrier_post(unsigned* bar, volatile LAS unsigned* st) {
    XcdBarrier b; b.bar = bar; b.x = xb_xcc_id(); b.st = st;
    if (threadIdx.x == 0) (void)xb_add(&bar[XB_XCNT(b.x)], 1u);
    return b;
}
__device__ __forceinline__ void xcd_barrier_complete(unsigned* bar, unsigned x, unsigned& nloc, unsigned& nx) {
    const unsigned G = gridDim.x * gridDim.y * gridDim.z;
    unsigned sum, cnt, mine, sp = 0u;
    for (;;) {
        sum = 0u; cnt = 0u; mine = 0u;
#pragma unroll
        for (unsigned j = 0; j < 16; ++j) { const unsigned c = xb_ld(&bar[XB_XCNT(j)]); sum += c; cnt += (c > 0u) ? 1u : 0u; mine = (j == x) ? c : mine; }
        if (sum == G) break;
        __builtin_amdgcn_s_sleep(1);
        if ((++sp & 255u) == 0u) { if (xb_ld(&bar[XB_TMO])) break; if (sp > XB_SPIN_CAP) { atomicAdd(&bar[XB_TMO], 1u); break; } }
    }
    nloc = mine > 0u ? mine : 1u; nx = cnt > 0u ? cnt : 1u;
}
__device__ __forceinline__ void xcd_barrier(const XcdBarrier& b) {
    asm volatile("s_waitcnt vmcnt(0)" ::: "memory");
    __syncthreads();
    if (threadIdx.x == 0) {
        unsigned* bar = b.bar;
        __builtin_amdgcn_s_waitcnt(0);
        unsigned nloc = b.st[0], nx = b.st[1];
        if (nloc == 0u) { xcd_barrier_complete(bar, b.x, nloc, nx); b.st[0] = nloc; b.st[1] = nx; }
        const unsigned old = xb_add(&bar[XB_XSUB(b.x)], 1u);
        const unsigned gen = old / nloc;
        if (old + 1u == (gen + 1u) * nloc) {
            __builtin_amdgcn_fence(__ATOMIC_RELEASE, "agent");
            asm volatile("s_waitcnt vmcnt(0)" ::: "memory");
            const unsigned og = xb_add(&bar[XB_TOP], 1u);
            const unsigned tg = og / nx;
            if (og + 1u == (tg + 1u) * nx) xb_add(&bar[XB_TOPGEN], 1u);
            else XB_SPIN(xb_ld(&bar[XB_TOPGEN]) == tg, bar);
            __builtin_amdgcn_fence(__ATOMIC_ACQUIRE, "agent");
            xb_add(&bar[XB_XGEN(b.x)], 1u);
            asm volatile("s_waitcnt vmcnt(0)" ::: "memory");
        } else {
            XB_SPIN(xb_ld(&bar[XB_XGEN(b.x)]) == gen, bar);
            __builtin_amdgcn_fence(__ATOMIC_ACQUIRE, "agent");
            asm volatile("s_waitcnt vmcnt(0)" ::: "memory");
        }
    }
    __syncthreads();
}

constexpr int LDS_BYTES = pg8::STAGE_BYTES + 64;
constexpr int N_PHASES = 25;

__global__ void __launch_bounds__(512, 2) fwd_megakernel(Args args) {
    extern __shared__ __attribute__((aligned(16))) unsigned char lds_raw[];
    LAS unsigned char* lds = (LAS unsigned char*)lds_raw;
    cg::grid_group grid = cg::this_grid();
    unsigned char* ws = args.ws;
    const int lo = args.ph_lo, hi = args.ph_hi;
    const int G = gridDim.x, bx = blockIdx.x;
    unsigned* barw = (unsigned*)ws;
    volatile LAS unsigned* bst = (volatile LAS unsigned*)(lds + pg8::STAGE_BYTES);
    if (threadIdx.x == 0) { bst[0] = 0u; bst[1] = 0u; }
    __syncthreads();
    XcdBarrier xbar = xcd_barrier_post(barw, bst);
    if (hi > 1000000) grid.sync();
#define IN(k) (lo <= (k) && (k) < hi)
#define DUP(k) ((DUP_MASK >> (k)) & 1u)
#define RUN(k, ...) do { if (IN(k)) { __VA_ARGS__; if (DUP(k)) { __syncthreads(); __VA_ARGS__; } } } while (0)
#define SEAM(k) do { if (IN(k) && IN((k) + 1)) { xcd_barrier(xbar); } } while (0)

#define GEMM_FFN_IN(mi) do { pg8::Gemm g{(const bf16*)(ws + WS_XN), (const bf16*)(ws + WS_WFI) + (size_t)(mi) * 5632 * 1024, 1024, 1024, 1024, 0, 0}; \
        pg8::Order S; S.init(TOK, 5632, 1, G, bx); pg8::EpiSwiglu E{(bf16*)(ws + WS_HID)}; pg8::gemm_phase<pg8::EpiSwiglu>(lds, g, S, E); } while (0)
#define GEMM_FFN_OUT(mi) do { pg8::Gemm g{(const bf16*)(ws + WS_HID), (const bf16*)(ws + WS_WFO) + (size_t)(mi) * 1024 * 2816, 1408, 2816, 2816, 1408, 1408}; \
        pg8::Order S; S.init(TOK, 1024, 2, G, bx); pg8::EpiPart E{(bf16*)(ws + WS_P)}; pg8::gemm_phase<pg8::EpiPart>(lds, g, S, E); } while (0)

    RUN(0, phase_prep(args, lds);); SEAM(0);
    RUN(1, phase_combine(args, 1, 0, 0, 0, 0.f, 0, 0);); SEAM(1);
    RUN(2, GEMM_FFN_IN(0); if (G == 256 && bx >= 192) ada_items(args, lds, 144 + (bx - 192), 64, 216);); SEAM(2);
    RUN(3, GEMM_FFN_OUT(0);); SEAM(3);
    RUN(4, phase_combine(args, 0, 0, 0, 0, 0.5f, 0, 1);); SEAM(4);
    RUN(5, { pg8::Gemm g{(const bf16*)(ws + WS_XN), (const bf16*)(ws + WS_WRI), 1024, 1024, 1024, 0, 0};
        pg8::Order S; S.init(TOK, 2560, 1, G, bx); pg8::EpiRgIn E{(bf16*)(ws + WS_MIX), (bf16*)(ws + WS_P)}; pg8::gemm_phase<pg8::EpiRgIn>(lds, g, S, E);
        if (G == 256 && bx >= 64) { const int gw_ = (bx - 64) * 8 + (int)(threadIdx.x >> 6); convert_weights(args, lds, 1, gw_, 192 * 8, 0x7fffffff, gw_, 192 * 8); } }); SEAM(5);

    RUN(6, phase_rg(args, lds);); SEAM(6);
    RUN(7, phase_rg_fix(args);); SEAM(7);
    RUN(8, { pg8::Gemm g{(const bf16*)(ws + WS_HID), (const bf16*)(ws + WS_WRO), 640, 2560, 1280, 640, 640};
        pg8::Order S; S.init(TOK, 1024, 2, G, bx); pg8::EpiPart E{(bf16*)(ws + WS_P)}; pg8::gemm_phase<pg8::EpiPart>(lds, g, S, E); }); SEAM(8);
    RUN(9, phase_combine(args, 0, 0, 0, 1, 1.0f, 0, 2);); SEAM(9);
    RUN(10, GEMM_FFN_IN(1); if (G == 256 && bx >= 192) ada_items(args, lds, 216 + (bx - 192), 64, 288);); SEAM(10);
    RUN(11, GEMM_FFN_OUT(1);); SEAM(11);
    RUN(12, phase_combine(args, 0, 0, 0, 2, 0.5f, 1, 0);); SEAM(12);
    RUN(13, GEMM_FFN_IN(2);); SEAM(13);
    RUN(14, GEMM_FFN_OUT(2);); SEAM(14);
    RUN(15, phase_combine(args, 0, 0, 1, 0, 0.5f, 1, 1);); SEAM(15);
    RUN(16, { pg8::Gemm g{(const bf16*)(ws + WS_XN), (const bf16*)(ws + WS_WGI), 1024, 1024, 1024, 0, 0};
        pg8::Order S; S.init(TOK, GLA_NP, 1, G, bx); pg8::EpiGlaIn E{(bf16*)(ws + WS_MIX), (float*)(ws + WS_Z)}; pg8::gemm_phase<pg8::EpiGlaIn>(lds, g, S, E); }); SEAM(16);
    RUN(17, phase_gla_pre(args, lds);); SEAM(17);
    RUN(18, phase_gla_scan(args, lds); if (G == 256 && bx >= 64) { __syncthreads(); const int gw_ = (bx - 64) * 8 + (int)(threadIdx.x >> 6); convert_weights(args, lds, 2, gw_, 192 * 8, 0x7fffffff, gw_, 192 * 8); }); SEAM(18);
    RUN(19, phase_gla_norm(args);); SEAM(19);
    RUN(20, { pg8::Gemm g{(const bf16*)(ws + WS_XN), (const bf16*)(ws + WS_WGO), 512, 1024, 1024, 512, 512};
        pg8::Order S; S.init(TOK, 1024, 2, G, bx); pg8::EpiPart E{(bf16*)(ws + WS_P)}; pg8::gemm_phase<pg8::EpiPart>(lds, g, S, E); }); SEAM(20);
    RUN(21, phase_combine(args, 0, 0, 1, 1, 1.0f, 1, 2);); SEAM(21);
    RUN(22, GEMM_FFN_IN(3);); SEAM(22);
    RUN(23, GEMM_FFN_OUT(3);); SEAM(23);
    RUN(24, phase_combine(args, 0, 1, 1, 2, 0.5f, 0, 0););
#undef IN
#undef SEAM
}

extern "C" void kernel_launch(void* const* d_in, const int* in_sizes, int n_in, void* d_out, int out_size, void* d_ws, size_t ws_size, hipStream_t stream) {
    static int grid = 0;
    if (grid == 0) {
        if (n_in != 26 || ws_size < WS_END) { fprintf(stderr, "kernel_launch: expected 26 inputs and >= %zu bytes of workspace (got %d, %zu)\n", (size_t)WS_END, n_in, ws_size); grid = -1; return; }
        int dev = 0, cus = 0, per_cu = 0;
        if (hipGetDevice(&dev) != hipSuccess || hipDeviceGetAttribute(&cus, hipDeviceAttributeMultiprocessorCount, dev) != hipSuccess) { grid = -1; return; }
        if (hipFuncSetAttribute((const void*)fwd_megakernel, hipFuncAttributeMaxDynamicSharedMemorySize, LDS_BYTES) != hipSuccess) { fprintf(stderr, "kernel_launch: hipFuncSetAttribute failed\n"); grid = -1; return; }
        if (hipOccupancyMaxActiveBlocksPerMultiprocessor(&per_cu, (const void*)fwd_megakernel, 512, LDS_BYTES) != hipSuccess || per_cu < 1) { fprintf(stderr, "kernel_launch: occupancy query failed (%d)\n", per_cu); (void)hipGetLastError(); grid = -1; return; }
        grid = cus;
    }
    if (grid < 0) return;
    if (hipMemsetAsync(d_ws, 0, 16384, stream) != hipSuccess) { fprintf(stderr, "kernel_launch: hipMemsetAsync of the barrier words failed\n"); return; }
    Args a{};
    for (int i = 0; i < 26; ++i) a.in[i] = (const float*)d_in[i];
    a.out = (float*)d_out; a.ws = (unsigned char*)d_ws;
    a.ph_lo = 0; a.ph_hi = N_PHASES; void* kargs[] = {&a};
    hipError_t e = hipLaunchCooperativeKernel((const void*)fwd_megakernel, dim3(grid), dim3(512), kargs, LDS_BYTES, stream);
    if (e != hipSuccess) fprintf(stderr, "kernel_launch: cooperative launch failed: %s (grid %d)\n", hipGetErrorString(e), grid);
}
```

```cpp
#include <hip/hip_runtime.h>
#include <hip/hip_cooperative_groups.h>
#include <cstdio>
#include <cstdint>
namespace cg = cooperative_groups;


#ifndef DUP_MASK
#define DUP_MASK 0u
#endif
#define GAS __attribute__((address_space(1)))
#define LAS __attribute__((address_space(3)))
typedef unsigned short bf16;
typedef unsigned v4u __attribute__((ext_vector_type(4)));
typedef unsigned v2u __attribute__((ext_vector_type(2)));
typedef float f32x4 __attribute__((ext_vector_type(4)));
typedef float f32x2 __attribute__((ext_vector_type(2)));
typedef short bf16x8 __attribute__((ext_vector_type(8)));

constexpr int DM = 1024, TOK = 8192, NPROMPT = 4096, DFF = 2816, DRNN = 1280;
constexpr int GLA_N = 3104, GLA_NP = 3328, PROJ_LD = 3072;
constexpr float EPS = 1e-6f;
constexpr size_t OUT_RG = (size_t)TOK * DM, OUT_GLA = OUT_RG + 16 * 2 * 1280;

constexpr size_t MiB = 1u << 20;
constexpr size_t WS_MOD = MiB / 2;
constexpr size_t WS_WFI = 1 * MiB;
constexpr size_t WS_WFO = 45 * MiB;
constexpr size_t WS_WRI = 67 * MiB;
constexpr size_t WS_WRO = 72 * MiB;
constexpr size_t WS_WGI = 75 * MiB;
constexpr size_t WS_WGO = 82 * MiB;
constexpr size_t WS_WGT = 84 * MiB;
constexpr size_t WS_XN  = 86 * MiB;
constexpr size_t WS_P   = 102 * MiB;
constexpr size_t WS_HID = 166 * MiB;
constexpr size_t WS_MIX = 210 * MiB;
constexpr size_t WS_Z   = WS_MIX + 48 * MiB;
constexpr size_t WS_PG  = 230 * MiB;
constexpr size_t WS_SEG = 259 * MiB;
constexpr size_t WS_QF = 166 * MiB, WS_KF = 182 * MiB, WS_DEC = 198 * MiB, WS_PF = 199 * MiB;
constexpr size_t WS_VF = 260 * MiB;
constexpr size_t WS_END = 276 * MiB;

typedef __bf16 bf16x2_t __attribute__((ext_vector_type(2)));
__device__ __forceinline__ unsigned cvt_pk_bf16(float lo, float hi) { f32x2 v = {lo, hi}; bf16x2_t b = __builtin_convertvector(v, bf16x2_t); return __builtin_bit_cast(unsigned, b); }
__device__ __forceinline__ float bf2f(unsigned short b) { return __uint_as_float(((unsigned)b) << 16); }
__device__ __forceinline__ float bflo(unsigned u) { return __uint_as_float(u << 16); }
__device__ __forceinline__ float bfhi(unsigned u) { return __uint_as_float(u & 0xffff0000u); }
__device__ __forceinline__ float fast_sigmoid(float x) { return __builtin_amdgcn_rcpf(1.0f + __expf(-x)); }
__device__ __forceinline__ float silu_f(float x) { return x * fast_sigmoid(x); }
__device__ __forceinline__ float gelu_tanh_f(float x) { return x * fast_sigmoid(1.5957691216057308f * (x + 0.044715f * x * x * x)); }
__device__ __forceinline__ float dpp_add(float v, const int ctrl_sel) {
    int r;
    switch (ctrl_sel) {
        case 0:  r = __builtin_amdgcn_update_dpp(0, __builtin_bit_cast(int, v), 0xB1, 0xF, 0xF, true); break;
        case 1:  r = __builtin_amdgcn_update_dpp(0, __builtin_bit_cast(int, v), 0x4E, 0xF, 0xF, true); break;
        case 2:  r = __builtin_amdgcn_update_dpp(0, __builtin_bit_cast(int, v), 0x141, 0xF, 0xF, true); break;
        default: r = __builtin_amdgcn_update_dpp(0, __builtin_bit_cast(int, v), 0x140, 0xF, 0xF, true); break;
    }
    return v + __builtin_bit_cast(float, r);
}
__device__ __forceinline__ float wave_sum(float v) {
    v = dpp_add(v, 0); v = dpp_add(v, 1); v = dpp_add(v, 2); v = dpp_add(v, 3);
    const int iv = __builtin_bit_cast(int, v);
    const float r0 = __builtin_bit_cast(float, __builtin_amdgcn_readlane(iv, 0)), r1 = __builtin_bit_cast(float, __builtin_amdgcn_readlane(iv, 16));
    const float r2 = __builtin_bit_cast(float, __builtin_amdgcn_readlane(iv, 32)), r3 = __builtin_bit_cast(float, __builtin_amdgcn_readlane(iv, 48));
    return (r0 + r1) + (r2 + r3);
}
#define LDS_BAR() do { asm volatile("s_waitcnt lgkmcnt(0)" ::: "memory"); __builtin_amdgcn_s_barrier(); asm volatile("" ::: "memory"); } while (0)
namespace pg8 {
#define PG8_LAS __attribute__((address_space(3)))
typedef unsigned short bf16_t;
constexpr int BM = 256, BK = 64, HALF = 128, HTB = HALF * BK * 2, STAGE_BYTES = 8 * HTB, NXCD = 8, WGM = 8;

__host__ __device__ __forceinline__ int lds_byte(int r, int c) { const int st = (r >> 4) * 2 + (c >> 5), rr = r & 15, cc = c & 31, ob = rr * 64 + cc * 2; return st * 1024 + (ob ^ (((ob >> 9) & 1) << 5)); }
__host__ __device__ __forceinline__ void stage_rc(int b, int& R, int& C) { const int st = b / 1024, sb = b % 1024, swz = sb ^ (((sb >> 9) & 1) << 5); R = (st >> 1) * 16 + swz / 64; C = (st & 1) * 32 + (swz % 64) / 2; }
__host__ __device__ __forceinline__ int perm32(int rho) { const int n = rho >> 4, i = rho & 15; return 8 * (i >> 2) + 4 * n + (i & 3); }

struct Unit { int pm, pn, ks; };
struct Gemm { const bf16_t* A; const bf16_t* Bt; int K, lda, ldb, ksA, ksB; };

struct Order {
    int nM, nNv, nNr, nwg, G, c;
    __device__ void init(int M, int Nreal, int nsplit, int G_, int c_) { nM = M / BM; nNr = Nreal / BM; nNv = nNr * nsplit; nwg = nM * nNv; G = G_; c = c_; }
    __device__ bool next(int i, Unit& u) const {
        const long L = (long)i * G + c; if (L >= nwg) return false;
        int wgid = (int)L; { const int q = nwg / NXCD, r = nwg % NXCD, xcd = wgid % NXCD, off = wgid / NXCD; wgid = (xcd < r ? xcd * (q + 1) : r * (q + 1) + (xcd - r) * q) + off; }
        const int nig = WGM * nNv, gid = wgid / nig, fm = gid * WGM, gsz = (nM - fm) < WGM ? (nM - fm) : WGM;
        u.pm = fm + ((wgid % nig) % gsz); const int pv = (wgid % nig) / gsz; u.pn = pv % nNr; u.ks = pv / nNr; return true;
    }
};

template <class Epi>
__device__ __forceinline__ void gemm_phase(PG8_LAS unsigned char* lds, const Gemm g, const Order& S, const Epi& E) {
    const int tid = threadIdx.x, wid = __builtin_amdgcn_readfirstlane(tid >> 6), lane = tid & 63, wr = wid >> 2, wc = wid & 3, fr = lane & 15, fq = lane >> 4;
    const int K = g.K, nt = K / BK;
    unsigned voffA[2], voffB[2];
#pragma unroll
    for (int i = 0; i < 2; ++i) { int R, C; stage_rc(tid * 16 + i * 8192, R, C); const int Rb = Epi::PERM ? ((R & ~31) + perm32(R & 31)) : R;
        voffA[i] = (unsigned)(R * g.lda + C) * 2u; voffB[i] = (unsigned)(Rb * g.ldb + C) * 2u; }
    const size_t kstep = (size_t)(BK * 2);
    const size_t hstepA = (size_t)HALF * g.lda * 2, hstepB = (size_t)HALF * g.ldb * 2;
    const unsigned ldsw = (unsigned)wid * 1024u;
    const int aoff = lds_byte(wr * 64 + fr, fq * 8), boff = lds_byte(wc * 32 + fr, fq * 8);
#define PG8_SA(b, h) (((b) * 2 + (h)) * HTB)
#define PG8_SB(b, h) ((4 + (b) * 2 + (h)) * HTB)
#define PG8_STAGE(bufoff, gbase, voff) do { _Pragma("unroll") for (int _i = 0; _i < 2; ++_i) \
        __builtin_amdgcn_global_load_lds((const unsigned*)((const char*)(gbase) + (voff)[_i]), (PG8_LAS unsigned*)(lds + (bufoff) + ldsw + _i * 8192), 16, 0, 0); } while (0)
#define PG8_LDA(dst, b, h) do { _Pragma("unroll") for (int m = 0; m < 4; ++m) _Pragma("unroll") for (int k = 0; k < 2; ++k) dst[m][k] = *(const PG8_LAS bf16x8*)(lds + PG8_SA(b, h) + aoff + m * 2048 + k * 1024); } while (0)
#define PG8_LDB(dst, b, h) do { _Pragma("unroll") for (int n = 0; n < 2; ++n) _Pragma("unroll") for (int k = 0; k < 2; ++k) dst[n][k] = *(const PG8_LAS bf16x8*)(lds + PG8_SB(b, h) + boff + n * 2048 + k * 1024); } while (0)
#define PG8_MMA(ai, bj, At, Bt) do { __builtin_amdgcn_s_setprio(1); _Pragma("unroll") for (int m = 0; m < 4; ++m) _Pragma("unroll") for (int n = 0; n < 2; ++n) _Pragma("unroll") for (int k = 0; k < 2; ++k) \
        acc[ai][bj][m][n] = __builtin_amdgcn_mfma_f32_16x16x32_bf16(Bt[n][k], At[m][k], acc[ai][bj][m][n], 0, 0, 0); __builtin_amdgcn_s_setprio(0); } while (0)
#define PG8_WAIT_V(n) asm volatile("s_waitcnt vmcnt(" #n ")" ::: "memory")
#define PG8_WAIT_L(n) asm volatile("s_waitcnt lgkmcnt(" #n ")" ::: "memory")
#define PG8_BAR __builtin_amdgcn_s_barrier()
#define PG8_SCHED __builtin_amdgcn_sched_barrier(0)
#define PG8_UA(u) ((const char*)g.A + (size_t)(u).pm * 2 * hstepA + (size_t)(u).ks * g.ksA * 2)
#define PG8_UB(u) ((const char*)g.Bt + (size_t)(u).pn * 2 * hstepB + (size_t)(u).ks * g.ksB * 2)
    Unit cur, nxt; int ui = 0;
    if (!S.next(0, cur)) return;
    f32x4 acc[2][2][4][2];
#pragma unroll
    for (int a = 0; a < 2; ++a)
#pragma unroll
        for (int b = 0; b < 2; ++b)
#pragma unroll
            for (int m = 0; m < 4; ++m)
#pragma unroll
                for (int n = 0; n < 2; ++n) acc[a][b][m][n] = (f32x4){0.f, 0.f, 0.f, 0.f};
    bf16x8 At[4][2], B0[2][2], B1[2][2];
    const char* cA = PG8_UA(cur); const char* cB = PG8_UB(cur);
    PG8_STAGE(PG8_SB(0, 0), cB, voffB); PG8_STAGE(PG8_SB(0, 1), cB + hstepB, voffB); PG8_STAGE(PG8_SA(0, 0), cA, voffA); PG8_STAGE(PG8_SA(0, 1), cA + hstepA, voffA);
    if (wr == 1) PG8_BAR;
    PG8_WAIT_V(2); PG8_BAR;
    PG8_STAGE(PG8_SB(1, 0), cB + kstep, voffB); PG8_STAGE(PG8_SA(1, 0), cA + kstep, voffA); PG8_STAGE(PG8_SB(1, 1), cB + hstepB + kstep, voffB);
    PG8_WAIT_V(6); PG8_BAR;
    for (;;) {
        const bool has_next = S.next(ui + 1, nxt);
        const char* nA = has_next ? PG8_UA(nxt) : cA; const char* nB = has_next ? PG8_UB(nxt) : cB;
        for (int t = 0; t < nt; t += 2) {
            const bool last = (t == nt - 2);
            const char* a1 = cA + (size_t)(t + 1) * kstep;
            const char* a2 = last ? nA : cA + (size_t)(t + 2) * kstep; const char* b2 = last ? nB : cB + (size_t)(t + 2) * kstep;
            const char* a3 = a2 + kstep; const char* b3 = b2 + kstep;
            PG8_LDB(B0, 0, 0); PG8_LDB(B1, 0, 1); PG8_SCHED; PG8_LDA(At, 0, 0); PG8_STAGE(PG8_SA(1, 1), a1 + hstepA, voffA);
            PG8_WAIT_V(8); PG8_WAIT_L(0); PG8_BAR; PG8_MMA(0, 0, At, B0); PG8_MMA(0, 1, At, B1); PG8_BAR; PG8_SCHED;
            PG8_LDA(At, 0, 1); PG8_STAGE(PG8_SB(0, 0), b2, voffB); PG8_STAGE(PG8_SB(0, 1), b2 + hstepB, voffB); PG8_STAGE(PG8_SA(0, 0), a2, voffA);
            PG8_WAIT_V(8); PG8_WAIT_L(0); PG8_BAR; PG8_MMA(1, 0, At, B0); PG8_MMA(1, 1, At, B1); PG8_BAR; PG8_SCHED;
            PG8_LDB(B0, 1, 0); PG8_LDB(B1, 1, 1); PG8_SCHED; PG8_LDA(At, 1, 0); PG8_STAGE(PG8_SA(0, 1), a2 + hstepA, voffA);
            PG8_WAIT_V(8); PG8_WAIT_L(0); PG8_BAR; PG8_MMA(0, 0, At, B0); PG8_MMA(0, 1, At, B1); PG8_BAR; PG8_SCHED;
            PG8_LDA(At, 1, 1); PG8_STAGE(PG8_SB(1, 0), b3, voffB); PG8_STAGE(PG8_SB(1, 1), b3 + hstepB, voffB); PG8_STAGE(PG8_SA(1, 0), a3, voffA);
            PG8_WAIT_V(8); PG8_WAIT_L(0); PG8_BAR; PG8_MMA(1, 0, At, B0); PG8_MMA(1, 1, At, B1); PG8_BAR; PG8_SCHED;
        }
        if (wr == 0) PG8_BAR;
        E(acc, cur, wr, wc, fr, fq);
        if (!has_next) break;
#pragma unroll
        for (int a = 0; a < 2; ++a)
#pragma unroll
            for (int b = 0; b < 2; ++b)
#pragma unroll
                for (int m = 0; m < 4; ++m)
#pragma unroll
                    for (int n = 0; n < 2; ++n) acc[a][b][m][n] = (f32x4){0.f, 0.f, 0.f, 0.f};
        cur = nxt; cA = nA; cB = nB; ++ui;
        if (wr == 1) PG8_BAR;
    }
    PG8_WAIT_V(0);
    PG8_BAR;
#undef PG8_SA
#undef PG8_SB
#undef PG8_STAGE
#undef PG8_LDA
#undef PG8_LDB
#undef PG8_MMA
#undef PG8_WAIT_V
#undef PG8_WAIT_L
#undef PG8_BAR
#undef PG8_SCHED
#undef PG8_UA
#undef PG8_UB
}

struct EpiSwiglu {
    static constexpr bool PERM = true;
    bf16_t* H;
    __device__ __forceinline__ void operator()(const f32x4 (&acc)[2][2][4][2], const Unit& u, int wr, int wc, int fr, int fq) const {
        const int row0 = u.pm * BM + wr * 64 + fr, colh = u.pn * 128 + wc * 32 + 8 * fq;
#pragma unroll
        for (int ai = 0; ai < 2; ++ai)
#pragma unroll
            for (int m = 0; m < 4; ++m) {
                const f32x4 g0 = acc[ai][0][m][0], g1 = acc[ai][0][m][1], u0 = acc[ai][1][m][0], u1 = acc[ai][1][m][1];
                v4u w;
                w.x = cvt_pk_bf16(silu_f(g0[0]) * u0[0], silu_f(g0[1]) * u0[1]); w.y = cvt_pk_bf16(silu_f(g0[2]) * u0[2], silu_f(g0[3]) * u0[3]);
                w.z = cvt_pk_bf16(silu_f(g1[0]) * u1[0], silu_f(g1[1]) * u1[1]); w.w = cvt_pk_bf16(silu_f(g1[2]) * u1[2], silu_f(g1[3]) * u1[3]);
                *(v4u*)(H + (size_t)(row0 + ai * HALF + m * 16) * DFF + colh) = w;
            }
    }
};
struct EpiPart {
    static constexpr bool PERM = true;
    bf16_t* P;
    __device__ __forceinline__ void operator()(const f32x4 (&acc)[2][2][4][2], const Unit& u, int wr, int wc, int fr, int fq) const {
        bf16_t* base = P + (size_t)u.ks * TOK * DM + (size_t)(u.pm * BM + wr * 64 + fr) * DM + u.pn * BM + wc * 32 + 8 * fq;
#pragma unroll
        for (int ai = 0; ai < 2; ++ai)
#pragma unroll
            for (int m = 0; m < 4; ++m)
#pragma unroll
                for (int bj = 0; bj < 2; ++bj) { const f32x4 a = acc[ai][bj][m][0], b = acc[ai][bj][m][1];
                    *(v4u*)(base + (size_t)(ai * HALF + m * 16) * DM + bj * HALF) = (v4u){cvt_pk_bf16(a[0], a[1]), cvt_pk_bf16(a[2], a[3]), cvt_pk_bf16(b[0], b[1]), cvt_pk_bf16(b[2], b[3])}; }
    }
};
struct EpiRgIn {
    static constexpr bool PERM = true;
    bf16_t* GG; bf16_t* XBR;
    __device__ __forceinline__ void operator()(const f32x4 (&acc)[2][2][4][2], const Unit& u, int wr, int wc, int fr, int fq) const {
        const int row0 = u.pm * BM + wr * 64 + fr;
        if (u.pn < 5) {
            const int col0 = u.pn * BM + wc * 32 + 8 * fq;
#pragma unroll
            for (int ai = 0; ai < 2; ++ai)
#pragma unroll
                for (int m = 0; m < 4; ++m)
#pragma unroll
                    for (int bj = 0; bj < 2; ++bj) {
                        const f32x4 a = acc[ai][bj][m][0], b = acc[ai][bj][m][1]; v4u w;
                        w.x = cvt_pk_bf16(gelu_tanh_f(a[0]), gelu_tanh_f(a[1])); w.y = cvt_pk_bf16(gelu_tanh_f(a[2]), gelu_tanh_f(a[3]));
                        w.z = cvt_pk_bf16(gelu_tanh_f(b[0]), gelu_tanh_f(b[1])); w.w = cvt_pk_bf16(gelu_tanh_f(b[2]), gelu_tanh_f(b[3]));
                        *(v4u*)(GG + (size_t)(row0 + ai * HALF + m * 16) * DRNN + col0 + bj * HALF) = w;
                    }
        } else {
            const int col0 = (u.pn - 5) * BM + wc * 32 + 8 * fq;
#pragma unroll
            for (int ai = 0; ai < 2; ++ai)
#pragma unroll
                for (int m = 0; m < 4; ++m)
#pragma unroll
                    for (int bj = 0; bj < 2; ++bj) {
                        const f32x4 a = acc[ai][bj][m][0], b = acc[ai][bj][m][1];
                        *(v4u*)(XBR + (size_t)(row0 + ai * HALF + m * 16) * DRNN + col0 + bj * HALF) = (v4u){cvt_pk_bf16(a[0], a[1]), cvt_pk_bf16(a[2], a[3]), cvt_pk_bf16(b[0], b[1]), cvt_pk_bf16(b[2], b[3])};
                    }
        }
    }
};
struct EpiGlaIn {
    static constexpr bool PERM = true;
    bf16_t* PROJ; float* Z;
    __device__ __forceinline__ void operator()(const f32x4 (&acc)[2][2][4][2], const Unit& u, int wr, int wc, int fr, int fq) const {
        const int row0 = u.pm * BM + wr * 64 + fr;
        if (u.pn < 12) {
            const int col0 = u.pn * BM + wc * 32 + 8 * fq;
            const float sc = (u.pn < 2) ? 0.08838834764831845f : 1.0f; const bool act = (u.pn >= 8);
#pragma unroll
            for (int ai = 0; ai < 2; ++ai)
#pragma unroll
                for (int m = 0; m < 4; ++m)
#pragma unroll
                    for (int bj = 0; bj < 2; ++bj) {
                        f32x4 a = acc[ai][bj][m][0] * sc, b = acc[ai][bj][m][1] * sc;
                        if (act) { a = (f32x4){silu_f(a[0]), silu_f(a[1]), silu_f(a[2]), silu_f(a[3])}; b = (f32x4){silu_f(b[0]), silu_f(b[1]), silu_f(b[2]), silu_f(b[3])}; }
                        v4u w; w.x = cvt_pk_bf16(a[0], a[1]); w.y = cvt_pk_bf16(a[2], a[3]); w.z = cvt_pk_bf16(b[0], b[1]); w.w = cvt_pk_bf16(b[2], b[3]);
                        *(v4u*)(PROJ + (size_t)(row0 + ai * HALF + m * 16) * PROJ_LD + col0 + bj * HALF) = w;
                    }
        } else if (wc == 0) {
#pragma unroll
            for (int ai = 0; ai < 2; ++ai)
#pragma unroll
                for (int m = 0; m < 4; ++m) {
                    float* p = Z + (size_t)(row0 + ai * HALF + m * 16) * 32 + 8 * fq;
                    *(f32x4*)p = acc[ai][0][m][0]; *(f32x4*)(p + 4) = acc[ai][0][m][1];
                }
        }
    }
};
}

struct Args { const float* in[26]; float* out; unsigned char* ws; int ph_lo, ph_hi; };
enum { I_XP = 0, I_XS, I_C, I_SRG, I_SGLA, I_CCTX, I_ADAW, I_ADAB, I_NORMG, I_FWI, I_FWO, I_RWI, I_RCW, I_RCB, I_RWA, I_RBA, I_RWIG, I_RBI, I_RLAM, I_RWO,
       I_GWI, I_GW2, I_GBG, I_GNORM, I_GWO, I_FNORM };

__device__ __forceinline__ void transpose_item(const float* W, int N, int k0, int n0, bf16* dst, int ldk, LAS float* scr, int lane) {
    float tv[32];
#pragma unroll
    for (int i = 0; i < 32; ++i) tv[i] = __builtin_nontemporal_load(&W[(size_t)(k0 + 2 * i + (lane >> 5)) * N + n0 + (lane & 31)]);
#pragma unroll
    for (int i = 0; i < 32; ++i) scr[(2 * i + (lane >> 5)) * 33 + (lane & 31)] = tv[i];
    asm volatile("s_waitcnt lgkmcnt(0)" ::: "memory");
    const int c = lane & 7;
#pragma unroll
    for (int j = 0; j < 4; ++j) { const int n = (lane >> 3) + 8 * j; const LAS float* s = scr + (8 * c) * 33 + n;
        v4u o; o.x = cvt_pk_bf16(s[0 * 33], s[1 * 33]); o.y = cvt_pk_bf16(s[2 * 33], s[3 * 33]); o.z = cvt_pk_bf16(s[4 * 33], s[5 * 33]); o.w = cvt_pk_bf16(s[6 * 33], s[7 * 33]);
        *(v4u*)(dst + (size_t)n * ldk + k0 + 8 * c) = o; }
    asm volatile("s_waitcnt lgkmcnt(0)" ::: "memory");
}

__device__ __forceinline__ void ada_items(const Args& a, LAS unsigned char* lds, const int first, const int stride, const int limit) {
    const int tid = threadIdx.x, lane = tid & 63, wave = tid >> 6;
    if (first >= limit) return;
    LAS float* sv = (LAS float*)lds;
    LAS float* red = (LAS float*)(lds + 12288);
    for (int i = tid; i < 3 * 1024; i += 512) { const int g = i >> 10, k = i & 1023; const float v = (g == 0) ? a.in[I_CCTX][k] : a.in[I_C][(g - 1) * 1024 + k]; sv[i] = silu_f(v); }
    __syncthreads();
    float* mod = (float*)(a.ws + WS_MOD);
    for (int it = first; it < limit; it += stride) {
        const int l = it / 144, n0 = (it % 144) * 64;
        const float* W = a.in[I_ADAW] + (size_t)l * 1024 * 9216 + n0 + lane;
        float a0 = 0.f, a1 = 0.f, a2 = 0.f;
        const int kb = wave * 128;
#pragma unroll 16
        for (int k = 0; k < 128; ++k) { const float wv = __builtin_nontemporal_load(&W[(size_t)(kb + k) * 9216]); a0 += sv[kb + k] * wv; a1 += sv[1024 + kb + k] * wv; a2 += sv[2048 + kb + k] * wv; }
        red[(wave * 3 + 0) * 64 + lane] = a0; red[(wave * 3 + 1) * 64 + lane] = a1; red[(wave * 3 + 2) * 64 + lane] = a2;
        __syncthreads();
        if (tid < 192) { const int g = tid >> 6, c = tid & 63; float sm = a.in[I_ADAB][l * 9216 + n0 + c];
#pragma unroll
            for (int w = 0; w < 8; ++w) sm += red[(w * 3 + g) * 64 + c];
            mod[(size_t)(l * 3 + g) * 9216 + n0 + c] = sm; }
        __syncthreads();
    }
}

__device__ __forceinline__ void convert_weights(const Args& a, LAS unsigned char* lds, const int group, const int first, const int step, const int end, const int gw, const int NGW) {
    const int lane = threadIdx.x & 63, wave = threadIdx.x >> 6;
    unsigned char* ws = a.ws;
    LAS float* scr = (LAS float*)(lds + wave * 16384);
    constexpr int I_FI = 16 * 176, I_FO = 44 * 32, I_RI = 16 * 80, I_RO = 20 * 32, I_GI = 16 * 97, I_GO = 16 * 32, I_GT = 8;
    const int mi0 = (group == 0) ? 0 : group + 1, nmi = (group == 0) ? 2 : 1;
    const int n_ri = (group == 0) ? I_RI : 0, n_ro = (group == 0) ? I_RO : 0, n_gt = (group == 0) ? 40 * I_GT : 0;
    const int n_gi = (group == 1) ? I_GI : 0, n_go = (group == 1) ? I_GO : 0;
    const int nitems = nmi * (I_FI + I_FO) + n_ri + n_ro + n_gi + n_go + n_gt;
    const int stop = end < nitems ? end : nitems;
    for (int it = first; it < stop; it += step) {
        int r = it;
        if (r < nmi * I_FI) { const int mi = mi0 + r / I_FI; r %= I_FI; const int kb = r / 176, n0 = (r % 176) * 32;
            const int drow = (n0 < DFF) ? (n0 / 128) * 256 + (n0 % 128) : ((n0 - DFF) / 128) * 256 + 128 + ((n0 - DFF) % 128);
            transpose_item(a.in[I_FWI] + (size_t)mi * 1024 * 5632, 5632, kb * 64, n0, (bf16*)(ws + WS_WFI) + ((size_t)mi * 5632 + drow) * 1024, 1024, scr, lane); continue; }
        r -= nmi * I_FI;
        if (r < nmi * I_FO) { const int mi = mi0 + r / I_FO; r %= I_FO; const int kb = r / 32, n0 = (r % 32) * 32;
            transpose_item(a.in[I_FWO] + (size_t)mi * 2816 * 1024, 1024, kb * 64, n0, (bf16*)(ws + WS_WFO) + ((size_t)mi * 1024 + n0) * 2816, 2816, scr, lane); continue; }
        r -= nmi * I_FO;
        if (r < n_ri) { const int kb = r / 80, n0 = (r % 80) * 32;
            transpose_item(a.in[I_RWI], 2560, kb * 64, n0, (bf16*)(ws + WS_WRI) + (size_t)n0 * 1024, 1024, scr, lane); continue; }
        r -= n_ri;
        if (r < n_ro) { const int kb = r / 32, n0 = (r % 32) * 32;
            transpose_item(a.in[I_RWO], 1024, kb * 64, n0, (bf16*)(ws + WS_WRO) + (size_t)n0 * 1280, 1280, scr, lane); continue; }
        r -= n_ro;
        if (r < n_gi) { const int kb = r / 97, n0 = (r % 97) * 32;
            transpose_item(a.in[I_GWI], GLA_N, kb * 64, n0, (bf16*)(ws + WS_WGI) + (size_t)n0 * 1024, 1024, scr, lane); continue; }
        r -= n_gi;
        if (r < n_go) { const int kb = r / 32, n0 = (r % 32) * 32;
            transpose_item(a.in[I_GWO], 1024, kb * 64, n0, (bf16*)(ws + WS_WGO) + (size_t)n0 * 1024, 1024, scr, lane); continue; }
        r -= n_go;
        { const int mi = r / I_GT; r %= I_GT; const int kb = r / 4, n0 = (r % 4) * 32;
          const int which = mi / 20, dn = mi % 20;
          const float* src = (which ? a.in[I_RWIG] : a.in[I_RWA]) + (size_t)dn * 128 * 128;
          transpose_item(src, 128, kb * 64, n0, (bf16*)(ws + WS_WGT) + ((size_t)dn * 256 + which * 128 + n0) * 128, 128, scr, lane); }
    }
    if (group == 1) {
        v4u* z = (v4u*)((bf16*)(ws + WS_WGI) + (size_t)GLA_N * 1024);
        const int nz = (GLA_NP - GLA_N) * 1024 * 2 / 16;
        for (int i = gw * 64 + lane; i < nz; i += NGW * 64) z[i] = (v4u){0u, 0u, 0u, 0u};
    }
}

__device__ __forceinline__ void phase_prep(const Args& a, LAS unsigned char* lds) {
    const int tid = threadIdx.x, lane = tid & 63, wave = tid >> 6;
    unsigned char* ws = a.ws;
    ada_items(a, lds, (int)blockIdx.x, (int)gridDim.x, (gridDim.x == 256) ? 144 : 288);
    __syncthreads();
    {
        const int gw = blockIdx.x * 8 + wave, NGW = gridDim.x * 8;
        if (gridDim.x == 256) {
            constexpr int N0 = 2 * (16 * 176) + 2 * (44 * 32) + 16 * 80 + 20 * 32 + 40 * 8, WTOT = 144 * 73 + 112 * 100;
            const int b = blockIdx.x;
            const int cw0 = (b < 144) ? 73 * b : 144 * 73 + 100 * (b - 144), cw1 = (b + 1 <= 144) ? 73 * (b + 1) : 144 * 73 + 100 * (b + 1 - 144);
            const int st = (int)(((long)N0 * cw0) / WTOT), en = (int)(((long)N0 * cw1) / WTOT);
            convert_weights(a, lds, 0, st + wave, 8, en, gw, NGW);
        } else {
            convert_weights(a, lds, 0, gw, NGW, 0x7fffffff, gw, NGW); convert_weights(a, lds, 1, gw, NGW, 0x7fffffff, gw, NGW); convert_weights(a, lds, 2, gw, NGW, 0x7fffffff, gw, NGW);
        }
    }
}

__device__ __forceinline__ void phase_combine(const Args& a, int first, int fin, int lg, int jg, float coef, int ln, int jn) {
    const int tid = threadIdx.x, lane = tid & 63, wave = tid >> 6;
    const int gw = blockIdx.x * 8 + wave, NGW = gridDim.x * 8;
    float* X = a.out; const float* mod = (const float*)(a.ws + WS_MOD); const bf16* P = (const bf16*)(a.ws + WS_P); bf16* XN = (bf16*)(a.ws + WS_XN);
    const bool aff = (gridDim.x == 256);
    const int affm0 = 2048 * ((blockIdx.x & 7) >> 1) + 32 * ((blockIdx.x & 1) * 32 + (blockIdx.x >> 3)) + 4 * wave;
    for (int m0 = aff ? affm0 : gw * 4; m0 < TOK; m0 += aff ? TOK : NGW * 4) {
        const int g = (m0 < NPROMPT) ? 0 : 1 + ((m0 - NPROMPT) >> 11);
        f32x4 cg[4], gs[4], sh[4];
#pragma unroll
        for (int j = 0; j < 4; ++j) {
            cg[j] = first ? (f32x4){0.f, 0.f, 0.f, 0.f} : coef * ((const f32x4*)(mod + (size_t)((lg * 3 + g) * 9 + 3 * jg + 2) * DM))[lane + 64 * j];
            if (fin) { gs[j] = ((const f32x4*)a.in[I_FNORM])[lane + 64 * j]; sh[j] = (f32x4){0.f, 0.f, 0.f, 0.f}; }
            else { gs[j] = ((const f32x4*)(a.in[I_NORMG] + (size_t)(ln * 3 + jn) * DM))[lane + 64 * j] * (1.0f + ((const f32x4*)(mod + (size_t)((ln * 3 + g) * 9 + 3 * jn + 1) * DM))[lane + 64 * j]);
                   sh[j] = ((const f32x4*)(mod + (size_t)((ln * 3 + g) * 9 + 3 * jn) * DM))[lane + 64 * j]; }
        }
#pragma unroll
        for (int r = 0; r < 4; ++r) {
            const int m = m0 + r;
            const float* xs = first ? ((m < NPROMPT) ? a.in[I_XP] + (size_t)m * DM : a.in[I_XS] + (size_t)(m - NPROMPT) * DM) : X + (size_t)m * DM;
            f32x4 v[4];
#pragma unroll
            for (int j = 0; j < 4; ++j) v[j] = first ? __builtin_nontemporal_load(&((const f32x4*)xs)[lane + 64 * j]) : ((const f32x4*)xs)[lane + 64 * j];
            if (!first) {
                const v2u* p0 = (const v2u*)(P + (size_t)m * DM); const v2u* p1 = (const v2u*)(P + (size_t)TOK * DM + (size_t)m * DM);
#pragma unroll
                for (int j = 0; j < 4; ++j) { const v2u a0 = p0[lane + 64 * j], a1 = p1[lane + 64 * j];
                    const f32x4 ps = (f32x4){bflo(a0.x) + bflo(a1.x), bfhi(a0.x) + bfhi(a1.x), bflo(a0.y) + bflo(a1.y), bfhi(a0.y) + bfhi(a1.y)};
                    v[j] += cg[j] * ps; }
            }
            float ss = 0.f;
#pragma unroll
            for (int j = 0; j < 4; ++j) ss += (v[j][0] * v[j][0] + v[j][1] * v[j][1]) + (v[j][2] * v[j][2] + v[j][3] * v[j][3]);
            const float rstd = 1.0f / sqrtf(wave_sum(ss) * (1.0f / DM) + EPS);
            if (fin) {
#pragma unroll
                for (int j = 0; j < 4; ++j) ((f32x4*)(X + (size_t)m * DM))[lane + 64 * j] = v[j] * rstd * gs[j];
            } else {
#pragma unroll
                for (int j = 0; j < 4; ++j) {
                    ((f32x4*)(X + (size_t)m * DM))[lane + 64 * j] = v[j];
                    const f32x4 y = (v[j] * rstd) * gs[j] + sh[j];
                    v2u w; w.x = cvt_pk_bf16(y[0], y[1]); w.y = cvt_pk_bf16(y[2], y[3]);
                    ((v2u*)(XN + (size_t)m * DM))[lane + 64 * j] = w;
                }
            }
        }
    }
}

__device__ __forceinline__ void phase_rg(const Args& a, LAS unsigned char* lds) {
    const int tid = threadIdx.x, lane = tid & 63, w = __builtin_amdgcn_readfirstlane(tid >> 6), l15 = lane & 15, lq = lane >> 4;
    unsigned char* ws = a.ws;
    const bf16* XBR = (const bf16*)(ws + WS_P);
    const bf16* GG = (const bf16*)(ws + WS_MIX);
    bf16* Y2 = (bf16*)(ws + WS_HID);
    bf16* PG = (bf16*)(ws + WS_PG);
    const bf16* WG = (const bf16*)(ws + WS_WGT);
    f32x2* SEG = (f32x2*)(ws + WS_SEG);
    LAS float* XCF = (LAS float*)lds;
    LAS unsigned short* XA = (LAS unsigned short*)(lds + 32768);
    LAS f32x2* AU = (LAS f32x2*)(lds + 50176);
    const int cc = tid & 127, tg = w >> 1;
    const int nitems = 320 + 640;
    const bool deal = (gridDim.x == 256);
    for (int kk = 0;; ++kk) {
        int it;
        if (deal) { const int b = blockIdx.x; if (kk > 3) break;
            if (kk == 0) it = b; else if (kk == 1) it = (b < 64) ? 256 + b : 320 + (b - 64); else if (kk == 2) it = 320 + 192 + b; else { if (b < 64) break; it = 320 + 448 + (b - 64); } }
        else { it = blockIdx.x + kk * gridDim.x; if (it >= nitems) break; }
        int s, r, pseg = 0, sb = 0;
        if (it < 320) { s = it / 20; r = it % 20; }
        else { const int q = it - 320; sb = q / 320; const int q2 = q % 320; pseg = q2 / 20; r = q2 % 20; s = 16 + sb; }
        const bool fix = (s >= 16 && pseg >= 1);
        const int n = r >> 1, d = r & 1;
        const int T = (s < 16) ? 256 : 2048, mb = (s < 16) ? s * 256 : NPROMPT + (s - 16) * 2048;
        const int ti0 = (s < 16) ? 0 : 2 * pseg, ti1 = (s < 16) ? 4 : 2 * pseg + 2;
        bf16x8 bfr[2][4];
        { const bf16* wg = WG + (size_t)((d * 10 + n) * 256) * 128;
#pragma unroll
          for (int f = 0; f < 2; ++f)
#pragma unroll
              for (int ks = 0; ks < 4; ++ks) bfr[f][ks] = *(const bf16x8*)(wg + (size_t)(f * 128 + 16 * w + l15) * 128 + 32 * ks + 8 * lq); }
        const int ch = 16 * w + l15, C = n * 128 + ch;
        const float ba = a.in[I_RBA][d * DRNN + C], bi = a.in[I_RBI][d * DRNN + C];
        float sp8; { const float nl = -a.in[I_RLAM][d * DRNN + C]; sp8 = 8.0f * (fmaxf(nl, 0.f) + log1pf(__expf(-fabsf(nl)))); }
        const int Cc = n * 128 + cc;
        const float w0 = a.in[I_RCW][Cc], w1 = a.in[I_RCW][DRNN + Cc], w2 = a.in[I_RCW][2 * DRNN + Cc], w3 = a.in[I_RCW][3 * DRNN + Cc], cb = a.in[I_RCB][Cc];
        float h = 0.f, pprod = 1.f;
        if (tid < 128 && s >= 16 && pseg == 0) h = a.in[I_SRG][((s - 16) * 2 + d) * DRNN + n * 128 + tid];
        unsigned xr[19]; unsigned ggp[8]; unsigned xm = 0u;
#pragma unroll
        for (int p = 0; p < 8; ++p) ggp[p] = 0u;
#define RG_LOAD(ti_) do { const int t0_ = d ? T - 64 * ((ti_) + 1) : 64 * (ti_); const int ts_ = t0_ + 16 * tg - 1; \
        const bf16* xp_ = XBR + (long)(mb + ts_) * DRNN + Cc; xm = 0u; \
        _Pragma("unroll") for (int i = 0; i < 19; ++i) { xr[i] = (unsigned)xp_[i * DRNN]; xm |= ((unsigned)(ts_ + i) < (unsigned)T) ? (1u << i) : 0u; } \
        const bf16* gp_ = GG + (size_t)(mb + t0_ + w) * DRNN + n * 128 + lane * 2; \
        _Pragma("unroll") for (int p = 0; p < 8; ++p) ggp[p] = *(const unsigned*)(gp_ + (size_t)(8 * p) * DRNN); } while (0)
        RG_LOAD(ti0);
        for (int ti = ti0; ti < ti1; ++ti) {
            const int t0 = d ? T - 64 * (ti + 1) : 64 * ti;
            float xv[19];
#pragma unroll
            for (int i = 0; i < 19; ++i) xv[i] = ((xm >> i) & 1u) ? __uint_as_float(xr[i] << 16) : 0.f;
#pragma unroll
            for (int i = 0; i < 16; ++i) { const float xc = cb + w0 * xv[i] + w1 * xv[i + 1] + w2 * xv[i + 2] + w3 * xv[i + 3];
                const int tl = 16 * tg + i; XCF[tl * 128 + cc] = xc; XA[tl * 136 + cc] = (unsigned short)(cvt_pk_bf16(xc, 0.f) & 0xffffu); }
            unsigned ggc[8];
#pragma unroll
            for (int p = 0; p < 8; ++p) ggc[p] = ggp[p];
            LDS_BAR();
            if (ti + 1 < ti1) RG_LOAD(ti + 1);
            f32x4 accA[4], accI[4]; float xcv[16];
#pragma unroll
            for (int mf = 0; mf < 4; ++mf) { accA[mf] = (f32x4){0.f, 0.f, 0.f, 0.f}; accI[mf] = (f32x4){0.f, 0.f, 0.f, 0.f}; }
#pragma unroll
            for (int e = 0; e < 16; ++e) xcv[e] = XCF[(16 * (e >> 2) + 4 * lq + (e & 3)) * 128 + ch];
#pragma unroll
            for (int ks = 0; ks < 4; ++ks)
#pragma unroll
                for (int mf = 0; mf < 4; ++mf) { const bf16x8 af = *(const LAS bf16x8*)(XA + (16 * mf + l15) * 136 + 32 * ks + 8 * lq);
                    accA[mf] = __builtin_amdgcn_mfma_f32_16x16x32_bf16(af, bfr[0][ks], accA[mf], 0, 0, 0);
                    accI[mf] = __builtin_amdgcn_mfma_f32_16x16x32_bf16(af, bfr[1][ks], accI[mf], 0, 0, 0); }
#pragma unroll
            for (int mf = 0; mf < 4; ++mf)
#pragma unroll
                for (int rg = 0; rg < 4; ++rg) { const int tl = 16 * mf + 4 * lq + rg;
                    const float rr = fast_sigmoid(accA[mf][rg] + ba), gi = fast_sigmoid(accI[mf][rg] + bi);
                    const float la = -sp8 * rr; const float av = __expf(la); const float uu = __builtin_amdgcn_sqrtf(fmaxf(1.0f - av * av, 0.f)) * gi * xcv[mf * 4 + rg];
                    AU[tl * 128 + ch] = (f32x2){av, uu}; }
            LDS_BAR();
            if (tid < 128) {
#pragma unroll 1
                for (int i0 = 0; i0 < 64; i0 += 8) {
                    f32x2 au[8];
#pragma unroll
                    for (int k = 0; k < 8; ++k) { const int tl = d ? 63 - (i0 + k) : i0 + k; au[k] = AU[tl * 128 + tid]; }
#pragma unroll
                    for (int k = 0; k < 8; ++k) { h = au[k].x * h + au[k].y; pprod *= au[k].x; au[k] = (f32x2){h, pprod}; }
#pragma unroll
                    for (int k = 0; k < 8; ++k) { const int tl = d ? 63 - (i0 + k) : i0 + k; AU[tl * 128 + tid] = au[k]; }
                }
            }
            LDS_BAR();
            f32x4 hp[8];
#pragma unroll
            for (int p = 0; p < 8; ++p) hp[p] = *(const LAS f32x4*)(AU + (8 * p + w) * 128 + lane * 2);
#pragma unroll
            for (int p = 0; p < 8; ++p) { const int tl = 8 * p + w, cp = lane * 2; const float g0 = bflo(ggc[p]), g1 = bfhi(ggc[p]);
                *(unsigned*)(Y2 + (size_t)(mb + t0 + tl) * (2 * DRNN) + d * DRNN + n * 128 + cp) = cvt_pk_bf16(hp[p][0] * g0, hp[p][2] * g1);
                if (fix) *(unsigned*)(PG + (size_t)(mb - NPROMPT + t0 + tl) * (2 * DRNN) + d * DRNN + n * 128 + cp) = cvt_pk_bf16(hp[p][1] * g0, hp[p][3] * g1); }
        }
        LDS_BAR();
#undef RG_LOAD
        if (tid < 128) {
            if (s < 16) a.out[OUT_RG + (size_t)(s * 2 + d) * DRNN + n * 128 + tid] = h;
            else SEG[(size_t)((sb * 16 + pseg) * 2 + d) * DRNN + n * 128 + tid] = (f32x2){pprod, h};
        }
    }
}

__device__ __forceinline__ void phase_rg_fix(const Args& a) {
    const int tid = threadIdx.x;
    unsigned char* ws = a.ws;
    bf16* Y2 = (bf16*)(ws + WS_HID); const bf16* PG = (const bf16*)(ws + WS_PG); const f32x2* SEG = (const f32x2*)(ws + WS_SEG);
    const int cp = (tid & 63) * 2, r8 = tid >> 6;
    for (int it = blockIdx.x; it < 640; it += gridDim.x) {
        const int n = it % 10, q = it / 10;
        const bool smp = q >= 32;
        const int sb = smp ? ((q - 32) >> 4) : 0, ts = smp ? ((q - 32) & 15) : 0;
        const int mb = smp ? NPROMPT + sb * 2048 + ts * 128 : q * 128;
        const int psf = smp ? ts : 0, psb = smp ? 15 - ts : 0;
        float hf0 = 0.f, hf1 = 0.f, hb0 = 0.f, hb1 = 0.f;
        if (smp) {
            f32x4 sf[15], sbk[15];
#pragma unroll
            for (int j = 0; j < 15; ++j) {
                sf[j]  = (j < psf) ? *(const f32x4*)(SEG + (size_t)((sb * 16 + j) * 2 + 0) * DRNN + n * 128 + cp) : (f32x4){1.f, 0.f, 1.f, 0.f};
                sbk[j] = (j < psb) ? *(const f32x4*)(SEG + (size_t)((sb * 16 + j) * 2 + 1) * DRNN + n * 128 + cp) : (f32x4){1.f, 0.f, 1.f, 0.f}; }
            hf0 = sf[0][1]; hf1 = sf[0][3]; hb0 = sbk[0][1]; hb1 = sbk[0][3];
#pragma unroll
            for (int j = 1; j < 15; ++j) { hf0 = sf[j][0] * hf0 + sf[j][1]; hf1 = sf[j][2] * hf1 + sf[j][3]; hb0 = sbk[j][0] * hb0 + sbk[j][1]; hb1 = sbk[j][2] * hb1 + sbk[j][3]; }
            if (psf == 0) { hf0 = 0.f; hf1 = 0.f; }
            if (psb == 0) { hb0 = 0.f; hb1 = 0.f; }
        }
        unsigned yf[16], yb[16], pf[16], pb[16];
#pragma unroll
        for (int i = 0; i < 16; ++i) { const size_t row = (size_t)(mb + 8 * i + r8);
            yf[i] = *(const unsigned*)(Y2 + row * (2 * DRNN) + n * 128 + cp); yb[i] = *(const unsigned*)(Y2 + row * (2 * DRNN) + DRNN + n * 128 + cp);
            pf[i] = (smp && psf >= 1) ? *(const unsigned*)(PG + (row - NPROMPT) * (2 * DRNN) + n * 128 + cp) : 0u;
            pb[i] = (smp && psb >= 1) ? *(const unsigned*)(PG + (row - NPROMPT) * (2 * DRNN) + DRNN + n * 128 + cp) : 0u; }
#pragma unroll
        for (int i = 0; i < 16; ++i) { const size_t row = (size_t)(mb + 8 * i + r8);
            const float s0 = (bflo(yf[i]) + bflo(pf[i]) * hf0) + (bflo(yb[i]) + bflo(pb[i]) * hb0), s1 = (bfhi(yf[i]) + bfhi(pf[i]) * hf1) + (bfhi(yb[i]) + bfhi(pb[i]) * hb1);
            *(unsigned*)(Y2 + row * (2 * DRNN) + n * 128 + cp) = cvt_pk_bf16(s0, s1); }
    }
}

#define GLA_ROW(tp_) (rbase + ((tp_) & rmask) * rmul + ((tp_) >> rshift))
__device__ __forceinline__ void phase_gla_pre(const Args& a, LAS unsigned char* lds) {
    const int tid = threadIdx.x, lane = tid & 63, w = tid >> 6, l15 = lane & 15, lq = lane >> 4;
    unsigned char* ws = a.ws;
    const bf16* PROJ = (const bf16*)(ws + WS_MIX); const float* Z = (const float*)(ws + WS_Z);
    v4u* QF = (v4u*)(ws + WS_QF); v4u* KF = (v4u*)(ws + WS_KF); float* DEC = (float*)(ws + WS_DEC); v4u* VF = (v4u*)(ws + WS_VF); v4u* PF = (v4u*)(ws + WS_PF);
    LAS unsigned short* QS = (LAS unsigned short*)lds;
    LAS unsigned short* KS = (LAS unsigned short*)(lds + 8704);
    LAS unsigned short* KT = (LAS unsigned short*)(lds + 17408);
    LAS unsigned short* PS = (LAS unsigned short*)(lds + 27648);
    LAS float* ZS = (LAS float*)(lds + 30208);
    LAS float* CS = (LAS float*)(lds + 32256);
    LAS unsigned short* VT = (LAS unsigned short*)(lds + 34304);
    const int dk = tid & 127, ig = tid >> 7;
    const int G = gridDim.x;
    const bool hoist = (G & 7) == 0;
    float w2r[16]; float bg = 0.f;
#define GP_W(g_) do { const int hh_ = (g_) & 3, d_ = ((g_) >> 2) & 1; \
        _Pragma("unroll") for (int q = 0; q < 16; ++q) w2r[q] = a.in[I_GW2][(size_t)(d_ * 16 + q) * 512 + hh_ * 128 + dk]; \
        bg = a.in[I_GBG][d_ * 512 + hh_ * 128 + dk]; } while (0)
    unsigned nq[8], nk[8]; float nz = 0.f; v4u nv0 = (v4u){0u, 0u, 0u, 0u}, nv1 = nv0;
#define GP_LOAD(g_) do { const int hh_ = (g_) & 3, d_ = ((g_) >> 2) & 1, cid_ = (g_) >> 3; \
        const int s_ = (cid_ < 128) ? (cid_ >> 3) : 16 + ((cid_ - 128) >> 6), cf_ = (cid_ < 128) ? (cid_ & 7) : ((cid_ - 128) & 63); \
        const int rbase = (s_ < 16) ? s_ * 256 : NPROMPT + (s_ - 16) * 2048, rmask = (s_ < 16) ? 0x7fffffff : 31, rmul = (s_ < 16) ? 1 : 64, rshift = (s_ < 16) ? 30 : 5; \
        _Pragma("unroll") for (int ii = 0; ii < 8; ++ii) { const int i = 8 * ig + ii; const int m = GLA_ROW(32 * cf_ + (d_ ? 31 - i : i)); \
            nq[ii] = PROJ[(size_t)m * PROJ_LD + hh_ * 128 + dk]; nk[ii] = PROJ[(size_t)m * PROJ_LD + 512 + hh_ * 128 + dk]; } \
        { const int iz = tid >> 4; const int mz = GLA_ROW(32 * cf_ + (d_ ? 31 - iz : iz)); nz = Z[(size_t)mz * 32 + d_ * 16 + (tid & 15)]; \
          const int i = tid & 31, cg = tid >> 5; const int m = GLA_ROW(32 * cf_ + (d_ ? 31 - i : i)); \
          const v4u* vp = (const v4u*)(PROJ + (size_t)m * PROJ_LD + 1024 + hh_ * 256 + cg * 16); nv0 = vp[0]; nv1 = vp[1]; } } while (0)
    if ((int)blockIdx.x < 2048) { GP_LOAD((int)blockIdx.x); if (hoist) GP_W((int)blockIdx.x); }
    for (int g = blockIdx.x; g < 2048; g += G) {
        const int hh = g & 3, d = (g >> 2) & 1, cid = g >> 3;
        if (!hoist) GP_W(g);
        unsigned pq[8], pk_[8];
#pragma unroll
        for (int ii = 0; ii < 8; ++ii) { pq[ii] = nq[ii]; pk_[ii] = nk[ii]; }
        { const int iz = tid >> 4; const int i = tid & 31, cg = tid >> 5;
          const v4u v0 = nv0, v1 = nv1;
          ZS[iz * 16 + (tid & 15)] = nz;
          LAS unsigned short* vt = VT + (cg * 16) * 40 + i;
          vt[0 * 40] = (unsigned short)(v0.x & 0xffffu); vt[1 * 40] = (unsigned short)(v0.x >> 16); vt[2 * 40] = (unsigned short)(v0.y & 0xffffu); vt[3 * 40] = (unsigned short)(v0.y >> 16);
          vt[4 * 40] = (unsigned short)(v0.z & 0xffffu); vt[5 * 40] = (unsigned short)(v0.z >> 16); vt[6 * 40] = (unsigned short)(v0.w & 0xffffu); vt[7 * 40] = (unsigned short)(v0.w >> 16);
          vt[8 * 40] = (unsigned short)(v1.x & 0xffffu); vt[9 * 40] = (unsigned short)(v1.x >> 16); vt[10 * 40] = (unsigned short)(v1.y & 0xffffu); vt[11 * 40] = (unsigned short)(v1.y >> 16);
          vt[12 * 40] = (unsigned short)(v1.z & 0xffffu); vt[13 * 40] = (unsigned short)(v1.z >> 16); vt[14 * 40] = (unsigned short)(v1.w & 0xffffu); vt[15 * 40] = (unsigned short)(v1.w >> 16); }
        if (g + G < 2048) GP_LOAD(g + G);
        LDS_BAR();
        float cum[8]; float run = 0.f;
#pragma unroll
        for (int ii = 0; ii < 8; ++ii) { const int i = 8 * ig + ii; float zz = bg;
#pragma unroll
            for (int q4 = 0; q4 < 4; ++q4) { const f32x4 zv = *(const LAS f32x4*)(ZS + i * 16 + 4 * q4);
                zz += zv[0] * w2r[4 * q4] + zv[1] * w2r[4 * q4 + 1] + zv[2] * w2r[4 * q4 + 2] + zv[3] * w2r[4 * q4 + 3]; }
            const float lg = (fminf(zz, 0.f) - __logf(1.0f + __expf(-fabsf(zz)))) * 0.0625f;
            run += lg; cum[ii] = run; }
        CS[ig * 128 + dk] = run;
        LDS_BAR();
        { float pre = 0.f, tot = 0.f;
#pragma unroll
          for (int g2 = 0; g2 < 4; ++g2) { const float v = CS[g2 * 128 + dk]; tot += v; if (g2 < ig) pre += v; }
          float k2[8];
#pragma unroll
          for (int ii = 0; ii < 8; ++ii) { const int i = 8 * ig + ii; const float b = pre + cum[ii];
              const float qv = __uint_as_float(pq[ii] << 16), kv = __uint_as_float(pk_[ii] << 16);
              QS[i * 136 + dk] = (unsigned short)(cvt_pk_bf16(qv * __expf(b), 0.f) & 0xffffu);
              KS[i * 136 + dk] = (unsigned short)(cvt_pk_bf16(kv * __expf(-b), 0.f) & 0xffffu);
              k2[ii] = kv * __expf(tot - b); }
          *(LAS v4u*)(KT + dk * 40 + 8 * ig) = (v4u){cvt_pk_bf16(k2[0], k2[1]), cvt_pk_bf16(k2[2], k2[3]), cvt_pk_bf16(k2[4], k2[5]), cvt_pk_bf16(k2[6], k2[7])};
          if (ig == 0) DEC[(size_t)g * 128 + dk] = __expf(tot); }
        LDS_BAR();
        if (w < 4) {
            const int mi2 = w >> 1, nj = w & 1; f32x4 sc = (f32x4){0.f, 0.f, 0.f, 0.f};
#pragma unroll
            for (int ks = 0; ks < 4; ++ks) { const bf16x8 aq = *(const LAS bf16x8*)(QS + (16 * mi2 + l15) * 136 + 32 * ks + 8 * lq);
                const bf16x8 bk = *(const LAS bf16x8*)(KS + (16 * nj + l15) * 136 + 32 * ks + 8 * lq);
                sc = __builtin_amdgcn_mfma_f32_16x16x32_bf16(aq, bk, sc, 0, 0, 0); }
#pragma unroll
            for (int rg = 0; rg < 4; ++rg) { const int i = 16 * mi2 + 4 * lq + rg, j = 16 * nj + l15;
                PS[i * 40 + j] = (unsigned short)(cvt_pk_bf16((j <= i) ? sc[rg] : 0.f, 0.f) & 0xffffu); }
        }
        { const int mi = w >> 2, ks = w & 3;
          const v2u lo = *(const LAS v2u*)(QS + (16 * mi + l15) * 136 + 32 * ks + 4 * lq), hi = *(const LAS v2u*)(QS + (16 * mi + l15) * 136 + 32 * ks + 16 + 4 * lq);
          QF[((size_t)g * 8 + w) * 64 + lane] = (v4u){lo.x, lo.y, hi.x, hi.y};
          KF[((size_t)g * 8 + w) * 64 + lane] = *(const LAS v4u*)(KT + (16 * w + l15) * 40 + 8 * lq);
          if (d == 0) {
#pragma unroll
              for (int h2 = 0; h2 < 2; ++h2) { const int nb = 2 * w + h2;
                  VF[((size_t)cid * 64 + hh * 16 + nb) * 64 + lane] = *(const LAS v4u*)(VT + (16 * nb + l15) * 40 + 8 * lq); } } }
        LDS_BAR();
        if (w < 2) PF[((size_t)g * 2 + w) * 64 + lane] = *(const LAS v4u*)(PS + (16 * w + l15) * 40 + 8 * lq);
    }
#undef GP_W
#undef GP_LOAD
}

__device__ __forceinline__ unsigned rot16(unsigned x) { return (x >> 16) | (x << 16); }
__device__ __forceinline__ void phase_gla_scan(const Args& a, LAS unsigned char* lds) {
    const int tid = threadIdx.x, lane = tid & 63, w = tid >> 6, l15 = lane & 15, lq = lane >> 4;
    unsigned char* ws = a.ws;
    const v4u* QF = (const v4u*)(ws + WS_QF); const v4u* KF = (const v4u*)(ws + WS_KF); const float* DEC = (const float*)(ws + WS_DEC); const v4u* VF = (const v4u*)(ws + WS_VF); const v4u* PF = (const v4u*)(ws + WS_PF);
    const int G = gridDim.x, b = blockIdx.x;
    LAS v4u* RING = (LAS v4u*)lds;
    for (int k = 0;; ++k) {
        const int it = (k & 1) ? k * G + (G - 1 - b) : k * G + b;
        if (it >= 64 + 256) break;
        const bool lng = it < 64; const int r = lng ? it : it - 64;
        const int hh = lng ? ((r >> 2) & 3) : ((r >> 1) & 3), d = lng ? ((r >> 4) & 1) : ((r >> 3) & 1), sq = lng ? (r >> 5) : (r >> 4);
        const bool act = lng ? (w < 4) : true;
        const int sl = lng ? (r & 3) * 4 + (w & 3) : (r & 1) * 8 + w, s = lng ? 16 + sq : sq;
        const int nch = lng ? 64 : 8, cid0 = lng ? 128 + sq * 64 : sq * 8;
        const int rbase = (s < 16) ? s * 256 : NPROMPT + (s - 16) * 2048, rmask = (s < 16) ? 0x7fffffff : 31, rmul = (s < 16) ? 1 : 64, rshift = (s < 16) ? 30 : 5;
        bf16* O = (bf16*)(ws + WS_P) + (size_t)d * TOK * DM + hh * 256 + 16 * sl + l15;
        const int vlane = d ? (l15 + 16 * (3 - lq)) : lane;
        bf16* op[2][4];
#pragma unroll
        for (int mi = 0; mi < 2; ++mi)
#pragma unroll
            for (int rg = 0; rg < 4; ++rg) { const int i = 16 * mi + 4 * lq + rg; const int ip = d ? 31 - i : i; op[mi][rg] = O + (size_t)(rbase + ip * ((s < 16) ? 1 : 64)) * DM; }
        const size_t cstride = (size_t)((s < 16) ? 32 : 1) * DM;
        f32x4 sacc[8];
#pragma unroll
        for (int f = 0; f < 8; ++f) {
            if (lng) { const float* sp = a.in[I_SGLA] + (size_t)((sq * 2 + d) * 4 + hh) * 32768 + (size_t)(16 * f + 4 * lq) * 256 + 16 * sl + l15;
                sacc[f] = (f32x4){sp[0], sp[256], sp[512], sp[768]}; }
            else sacc[f] = (f32x4){0.f, 0.f, 0.f, 0.f};
        }
        v4u qn[2][8], vn[2], kst[2], dsx[2], pn[2][2];
        dsx[0] = (v4u){0u, 0u, 0u, 0u}; dsx[1] = (v4u){0u, 0u, 0u, 0u};
#pragma unroll
        for (int u = 0; u < 2; ++u) { vn[u] = (v4u){0u, 0u, 0u, 0u}; pn[u][0] = vn[u]; pn[u][1] = vn[u];
#pragma unroll
            for (int q = 0; q < 8; ++q) qn[u][q] = vn[u]; }
#define GS_LOAD(u_, c_) do { const int cid_ = cid0 + (d ? nch - 1 - (c_) : (c_)); const size_t g_ = ((size_t)cid_ * 2 + d) * 4 + hh; \
        kst[u_] = KF[g_ * 512 + tid]; if (tid < 32) dsx[u_] = *(const v4u*)(DEC + g_ * 128 + 4 * tid); \
        if (act) { _Pragma("unroll") for (int q = 0; q < 8; ++q) qn[u_][q] = QF[(g_ * 8 + q) * 64 + lane]; \
        vn[u_] = VF[((size_t)cid_ * 64 + hh * 16 + sl) * 64 + vlane]; \
        pn[u_][0] = PF[(g_ * 2 + 0) * 64 + lane]; pn[u_][1] = PF[(g_ * 2 + 1) * 64 + lane]; } } while (0)
#define GS_STAGE(slot_, u_) do { RING[(slot_) * 544 + tid] = kst[u_]; if (tid < 32) RING[(slot_) * 544 + 512 + tid] = dsx[u_]; } while (0)
        GS_LOAD(0, 0); GS_LOAD(1, 1);
        GS_STAGE(0, 0);
        LDS_BAR();
        for (int c0 = 0; c0 < nch; c0 += 2) {
#pragma unroll
          for (int u = 0; u < 2; ++u) {
            const int c = c0 + u;
            const int cid = cid0 + (d ? nch - 1 - c : c); const int cf = cid - cid0;
            if (!act) { if (c + 2 < nch) GS_LOAD(u, c + 2); if (c + 1 < nch) GS_STAGE((c + 1) & 1, u ^ 1); LDS_BAR(); continue; }
            v4u qf[8]; f32x4 o[2];
#pragma unroll
            for (int q = 0; q < 8; ++q) qf[q] = qn[u][q];
            v4u vf = vn[u]; const v4u pf0 = pn[u][0], pf1 = pn[u][1];
            if (d) vf = (v4u){rot16(vf.w), rot16(vf.z), rot16(vf.y), rot16(vf.x)};
            const bf16x8 vb = __builtin_bit_cast(bf16x8, vf);
            if (c + 2 < nch) GS_LOAD(u, c + 2);
            o[0] = __builtin_amdgcn_mfma_f32_16x16x32_bf16(__builtin_bit_cast(bf16x8, pf0), vb, (f32x4){0.f, 0.f, 0.f, 0.f}, 0, 0, 0);
            o[1] = __builtin_amdgcn_mfma_f32_16x16x32_bf16(__builtin_bit_cast(bf16x8, pf1), vb, (f32x4){0.f, 0.f, 0.f, 0.f}, 0, 0, 0);
            const LAS v4u* slot = RING + (c & 1) * 544;
#pragma unroll
            for (int ks = 0; ks < 4; ++ks) {
                v4u sb; sb.x = cvt_pk_bf16(sacc[2 * ks][0], sacc[2 * ks][1]); sb.y = cvt_pk_bf16(sacc[2 * ks][2], sacc[2 * ks][3]);
                sb.z = cvt_pk_bf16(sacc[2 * ks + 1][0], sacc[2 * ks + 1][1]); sb.w = cvt_pk_bf16(sacc[2 * ks + 1][2], sacc[2 * ks + 1][3]);
                const bf16x8 sbv = __builtin_bit_cast(bf16x8, sb);
                o[0] = __builtin_amdgcn_mfma_f32_16x16x32_bf16(__builtin_bit_cast(bf16x8, qf[ks]), sbv, o[0], 0, 0, 0);
                o[1] = __builtin_amdgcn_mfma_f32_16x16x32_bf16(__builtin_bit_cast(bf16x8, qf[4 + ks]), sbv, o[1], 0, 0, 0);
            }
#pragma unroll
            for (int mi = 0; mi < 2; ++mi)
#pragma unroll
                for (int rg = 0; rg < 4; ++rg) op[mi][rg][(size_t)cf * cstride] = (bf16)(cvt_pk_bf16(o[mi][rg], 0.f) & 0xffffu);
#pragma unroll
            for (int f = 0; f < 8; ++f) { const v4u kfv = slot[f * 64 + lane]; const f32x4 dec = *(const LAS f32x4*)((const LAS float*)(slot + 512) + 16 * f + 4 * lq);
                sacc[f] = sacc[f] * dec; sacc[f] = __builtin_amdgcn_mfma_f32_16x16x32_bf16(__builtin_bit_cast(bf16x8, kfv), vb, sacc[f], 0, 0, 0); }
            if (c + 1 < nch) GS_STAGE((c + 1) & 1, u ^ 1);
            LDS_BAR();
          }
        }
#undef GS_LOAD
#undef GS_STAGE
        if (!lng) {
#pragma unroll
            for (int f = 0; f < 8; ++f) { float* dp = a.out + OUT_GLA + (size_t)((s * 2 + d) * 4 + hh) * 32768 + (size_t)(16 * f + 4 * lq) * 256 + 16 * sl + l15;
                dp[0] = sacc[f][0]; dp[256] = sacc[f][1]; dp[512] = sacc[f][2]; dp[768] = sacc[f][3]; }
        }
    }
}

__device__ __forceinline__ void phase_gla_norm(const Args& a) {
    const int tid = threadIdx.x, lane = tid & 63, wave = tid >> 6;
    const int gw = blockIdx.x * 8 + wave, NGW = gridDim.x * 8;
    const bf16* Of = (const bf16*)(a.ws + WS_P); const bf16* Ob = Of + (size_t)TOK * DM;
    const bf16* PROJ = (const bf16*)(a.ws + WS_MIX); bf16* AO = (bf16*)(a.ws + WS_XN);
    const bool aff = (gridDim.x == 256);
    const int affm0 = 2048 * ((blockIdx.x & 7) >> 1) + 32 * ((blockIdx.x & 1) * 32 + (blockIdx.x >> 3)) + 4 * wave;
    for (int m0 = aff ? affm0 : gw * 4; m0 < TOK; m0 += aff ? TOK : NGW * 4) {
        f32x4 gn[4];
#pragma unroll
        for (int j = 0; j < 4; ++j) gn[j] = ((const f32x4*)a.in[I_GNORM])[lane + 64 * j];
#pragma unroll
        for (int r = 0; r < 4; ++r) {
            const int m = m0 + r;
#pragma unroll
            for (int j = 0; j < 4; ++j) {
                const v2u of = ((const v2u*)(Of + (size_t)m * DM))[lane + 64 * j], ob = ((const v2u*)(Ob + (size_t)m * DM))[lane + 64 * j];
                const f32x4 v = (f32x4){bflo(of.x) + bflo(ob.x), bfhi(of.x) + bfhi(ob.x), bflo(of.y) + bflo(ob.y), bfhi(of.y) + bfhi(ob.y)};
                const float ss = wave_sum((v[0] * v[0] + v[1] * v[1]) + (v[2] * v[2] + v[3] * v[3]));
                const float rstd = 1.0f / sqrtf(ss * (1.0f / 256.0f) + EPS);
                const v2u sr = *(const v2u*)(PROJ + (size_t)m * PROJ_LD + 2048 + 256 * j + 4 * lane);
                v2u wv; wv.x = cvt_pk_bf16(v[0] * rstd * gn[j][0] * bflo(sr.x), v[1] * rstd * gn[j][1] * bfhi(sr.x));
                wv.y = cvt_pk_bf16(v[2] * rstd * gn[j][2] * bflo(sr.y), v[3] * rstd * gn[j][3] * bfhi(sr.y));
                ((v2u*)(AO + (size_t)m * DM))[lane + 64 * j] = wv;
            }
        }
    }
}

#define XB_TMO      128
#define XB_XCNT(j)  (256  + 64 * (j))
#define XB_XSUB(j)  (1280 + 64 * (j))
#define XB_XGEN(j)  (2304 + 64 * (j))
#define XB_TOP      3328
#define XB_TOPGEN   3392
#define XCD_BAR_WORDS 3456
#define XB_SPIN_CAP (1u << 18)
__device__ __forceinline__ unsigned xb_ld(unsigned* p)              { return __hip_atomic_load(p, __ATOMIC_RELAXED, __HIP_MEMORY_SCOPE_AGENT); }
__device__ __forceinline__ unsigned xb_add(unsigned* p, unsigned v) { return __hip_atomic_fetch_add(p, v, __ATOMIC_RELAXED, __HIP_MEMORY_SCOPE_AGENT); }
__device__ __forceinline__ unsigned xb_xcc_id() { return (unsigned)__builtin_amdgcn_s_getreg((3 << 11) | 20) & 0xFu; }
#define XB_SPIN(cond, bar) do { unsigned _sp = 0; while (cond) { __builtin_amdgcn_s_sleep(1); \
    if ((++_sp & 255u) == 0u) { if (xb_ld(&(bar)[XB_TMO])) break; if (_sp > XB_SPIN_CAP) { atomicAdd(&(bar)[XB_TMO], 1u); break; } } } } while (0)
struct XcdBarrier { unsigned* bar; unsigned x; volatile LAS unsigned* st; };
__device__ __forceinline__ XcdBarrier xcd_barrier_post(unsigned* bar, volatile LAS unsigned* st) {
    XcdBarrier b; b.bar = bar; b.x = xb_xcc_id(); b.st = st;
    if (threadIdx.x == 0) (void)xb_add(&bar[XB_XCNT(b.x)], 1u);
    return b;
}
__device__ __forceinline__ void xcd_barrier_complete(unsigned* bar, unsigned x, unsigned& nloc, unsigned& nx) {
    const unsigned G = gridDim.x * gridDim.y * gridDim.z;
    unsigned sum, cnt, mine, sp = 0u;
    for (;;) {
        sum = 0u; cnt = 0u; mine = 0u;
#pragma unroll
        for (unsigned j = 0; j < 16; ++j) { const unsigned c = xb_ld(&bar[XB_XCNT(j)]); sum += c; cnt += (c > 0u) ? 1u : 0u; mine = (j == x) ? c : mine; }
        if (sum == G) break;
        __builtin_amdgcn_s_sleep(1);
        if ((++sp & 255u) == 0u) { if (xb_ld(&bar[XB_TMO])) break; if (sp > XB_SPIN_CAP) { atomicAdd(&bar[XB_TMO], 1u); break; } }
    }
    nloc = mine > 0u ? mine : 1u; nx = cnt > 0u ? cnt : 1u;
}
__device__ __forceinline__ void xcd_barrier(const XcdBarrier& b) {
    asm volatile("s_waitcnt vmcnt(0)" ::: "memory");
    __syncthreads();
    if (threadIdx.x == 0) {
        unsigned* bar = b.bar;
        __builtin_amdgcn_s_waitcnt(0);
        unsigned nloc = b.st[0], nx = b.st[1];
        if (nloc == 0u) { xcd_barrier_complete(bar, b.x, nloc, nx); b.st[0] = nloc; b.st[1] = nx; }
        const unsigned old = xb_add(&bar[XB_XSUB(b.x)], 1u);
        const unsigned gen = old / nloc;
        if (old + 1u == (gen + 1u) * nloc) {
            __builtin_amdgcn_fence(__ATOMIC_RELEASE, "agent");
            asm volatile("s_waitcnt vmcnt(0)" ::: "memory");
            const unsigned og = xb_add(&bar[XB_TOP], 1u);
            const unsigned tg = og / nx;
            if (og + 1u == (tg + 1u) * nx) xb_add(&bar[XB_TOPGEN], 1u);
            else XB_SPIN(xb_ld(&bar[XB_TOPGEN]) == tg, bar);
            __builtin_amdgcn_fence(__ATOMIC_ACQUIRE, "agent");
            xb_add(&bar[XB_XGEN(b.x)], 1u);
            asm volatile("s_waitcnt vmcnt(0)" ::: "memory");
        } else {
            XB_SPIN(xb_ld(&bar[XB_XGEN(b.x)]) == gen, bar);
            __builtin_amdgcn_fence(__ATOMIC_ACQUIRE, "agent");
            asm volatile("s_waitcnt vmcnt(0)" ::: "memory");
        }
    }
    __syncthreads();
}

constexpr int LDS_BYTES = pg8::STAGE_BYTES + 64;
constexpr int N_PHASES = 25;

__global__ void __launch_bounds__(512, 2) fwd_megakernel(Args args) {
    extern __shared__ __attribute__((aligned(16))) unsigned char lds_raw[];
    LAS unsigned char* lds = (LAS unsigned char*)lds_raw;
    cg::grid_group grid = cg::this_grid();
    unsigned char* ws = args.ws;
    const int lo = args.ph_lo, hi = args.ph_hi;
    const int G = gridDim.x, bx = blockIdx.x;
    unsigned* barw = (unsigned*)ws;
    volatile LAS unsigned* bst = (volatile LAS unsigned*)(lds + pg8::STAGE_BYTES);
    if (threadIdx.x == 0) { bst[0] = 0u; bst[1] = 0u; }
    __syncthreads();
    XcdBarrier xbar = xcd_barrier_post(barw, bst);
    if (hi > 1000000) grid.sync();
#define IN(k) (lo <= (k) && (k) < hi)
#define DUP(k) ((DUP_MASK >> (k)) & 1u)
#define RUN(k, ...) do { if (IN(k)) { __VA_ARGS__; if (DUP(k)) { __syncthreads(); __VA_ARGS__; } } } while (0)
#define SEAM(k) do { if (IN(k) && IN((k) + 1)) { xcd_barrier(xbar); } } while (0)

#define GEMM_FFN_IN(mi) do { pg8::Gemm g{(const bf16*)(ws + WS_XN), (const bf16*)(ws + WS_WFI) + (size_t)(mi) * 5632 * 1024, 1024, 1024, 1024, 0, 0}; \
        pg8::Order S; S.init(TOK, 5632, 1, G, bx); pg8::EpiSwiglu E{(bf16*)(ws + WS_HID)}; pg8::gemm_phase<pg8::EpiSwiglu>(lds, g, S, E); } while (0)
#define GEMM_FFN_OUT(mi) do { pg8::Gemm g{(const bf16*)(ws + WS_HID), (const bf16*)(ws + WS_WFO) + (size_t)(mi) * 1024 * 2816, 1408, 2816, 2816, 1408, 1408}; \
        pg8::Order S; S.init(TOK, 1024, 2, G, bx); pg8::EpiPart E{(bf16*)(ws + WS_P)}; pg8::gemm_phase<pg8::EpiPart>(lds, g, S, E); } while (0)

    RUN(0, phase_prep(args, lds);); SEAM(0);
    RUN(1, phase_combine(args, 1, 0, 0, 0, 0.f, 0, 0);); SEAM(1);
    RUN(2, GEMM_FFN_IN(0); if (G == 256 && bx >= 192) ada_items(args, lds, 144 + (bx - 192), 64, 216);); SEAM(2);
    RUN(3, GEMM_FFN_OUT(0);); SEAM(3);
    RUN(4, phase_combine(args, 0, 0, 0, 0, 0.5f, 0, 1);); SEAM(4);
    RUN(5, { pg8::Gemm g{(const bf16*)(ws + WS_XN), (const bf16*)(ws + WS_WRI), 1024, 1024, 1024, 0, 0};
        pg8::Order S; S.init(TOK, 2560, 1, G, bx); pg8::EpiRgIn E{(bf16*)(ws + WS_MIX), (bf16*)(ws + WS_P)}; pg8::gemm_phase<pg8::EpiRgIn>(lds, g, S, E);
        if (G == 256 && bx >= 64) { const int gw_ = (bx - 64) * 8 + (int)(threadIdx.x >> 6); convert_weights(args, lds, 1, gw_, 192 * 8, 0x7fffffff, gw_, 192 * 8); } }); SEAM(5);

    RUN(6, phase_rg(args, lds);); SEAM(6);
    RUN(7, phase_rg_fix(args);); SEAM(7);
    RUN(8, { pg8::Gemm g{(const bf16*)(ws + WS_HID), (const bf16*)(ws + WS_WRO), 640, 2560, 1280, 640, 640};
        pg8::Order S; S.init(TOK, 1024, 2, G, bx); pg8::EpiPart E{(bf16*)(ws + WS_P)}; pg8::gemm_phase<pg8::EpiPart>(lds, g, S, E); }); SEAM(8);
    RUN(9, phase_combine(args, 0, 0, 0, 1, 1.0f, 0, 2);); SEAM(9);
    RUN(10, GEMM_FFN_IN(1); if (G == 256 && bx >= 192) ada_items(args, lds, 216 + (bx - 192), 64, 288);); SEAM(10);
    RUN(11, GEMM_FFN_OUT(1);); SEAM(11);
    RUN(12, phase_combine(args, 0, 0, 0, 2, 0.5f, 1, 0);); SEAM(12);
    RUN(13, GEMM_FFN_IN(2);); SEAM(13);
    RUN(14, GEMM_FFN_OUT(2);); SEAM(14);
    RUN(15, phase_combine(args, 0, 0, 1, 0, 0.5f, 1, 1);); SEAM(15);
    RUN(16, { pg8::Gemm g{(const bf16*)(ws + WS_XN), (const bf16*)(ws + WS_WGI), 1024, 1024, 1024, 0, 0};
        pg8::Order S; S.init(TOK, GLA_NP, 1, G, bx); pg8::EpiGlaIn E{(bf16*)(ws + WS_MIX), (float*)(ws + WS_Z)}; pg8::gemm_phase<pg8::EpiGlaIn>(lds, g, S, E); }); SEAM(16);
    RUN(17, phase_gla_pre(args, lds);); SEAM(17);
    RUN(18, phase_gla_scan(args, lds); if (G == 256 && bx >= 64) { __syncthreads(); const int gw_ = (bx - 64) * 8 + (int)(threadIdx.x >> 6); convert_weights(args, lds, 2, gw_, 192 * 8, 0x7fffffff, gw_, 192 * 8); }); SEAM(18);
    RUN(19, phase_gla_norm(args);); SEAM(19);
    RUN(20, { pg8::Gemm g{(const bf16*)(ws + WS_XN), (const bf16*)(ws + WS_WGO), 512, 1024, 1024, 512, 512};
        pg8::Order S; S.init(TOK, 1024, 2, G, bx); pg8::EpiPart E{(bf16*)(ws + WS_P)}; pg8::gemm_phase<pg8::EpiPart>(lds, g, S, E); }); SEAM(20);
    RUN(21, phase_combine(args, 0, 0, 1, 1, 1.0f, 1, 2);); SEAM(21);
    RUN(22, GEMM_FFN_IN(3);); SEAM(22);
    RUN(23, GEMM_FFN_OUT(3);); SEAM(23);
    RUN(24, phase_combine(args, 0, 1, 1, 2, 0.5f, 0, 0););
#undef IN
#undef SEAM
}

extern "C" void kernel_launch(void* const* d_in, const int* in_sizes, int n_in, void* d_out, int out_size, void* d_ws, size_t ws_size, hipStream_t stream) {
    static int grid = 0;
    if (grid == 0) {
        if (n_in != 26 || ws_size < WS_END) { fprintf(stderr, "kernel_launch: expected 26 inputs and >= %zu bytes of workspace (got %d, %zu)\n", (size_t)WS_END, n_in, ws_size); grid = -1; return; }
        int dev = 0, cus = 0, per_cu = 0;
        if (hipGetDevice(&dev) != hipSuccess || hipDeviceGetAttribute(&cus, hipDeviceAttributeMultiprocessorCount, dev) != hipSuccess) { grid = -1; return; }
        if (hipFuncSetAttribute((const void*)fwd_megakernel, hipFuncAttributeMaxDynamicSharedMemorySize, LDS_BYTES) != hipSuccess) { fprintf(stderr, "kernel_launch: hipFuncSetAttribute failed\n"); grid = -1; return; }
        if (hipOccupancyMaxActiveBlocksPerMultiprocessor(&per_cu, (const void*)fwd_megakernel, 512, LDS_BYTES) != hipSuccess || per_cu < 1) { fprintf(stderr, "kernel_launch: occupancy query failed (%d)\n", per_cu); (void)hipGetLastError(); grid = -1; return; }
        grid = cus;
    }
    if (grid < 0) return;
    if (hipMemsetAsync(d_ws, 0, 16384, stream) != hipSuccess) { fprintf(stderr, "kernel_launch: hipMemsetAsync of the barrier words failed\n"); return; }
    Args a{};
    for (int i = 0; i < 26; ++i) a.in[i] = (const float*)d_in[i];
    a.out = (float*)d_out; a.ws = (unsigned char*)d_ws;
    a.ph_lo = 0; a.ph_hi = N_PHASES; void* kargs[] = {&a};
    hipError_t e = hipLaunchCooperativeKernel((const void*)fwd_megakernel, dim3(grid), dim3(512), kargs, LDS_BYTES, stream);
    if (e != hipSuccess) fprintf(stderr, "kernel_launch: cooperative launch failed: %s (grid %d)\n", hipGetErrorString(e), grid);
}
```

```cpp
#include <hip/hip_runtime.h>
#include <hip/hip_cooperative_groups.h>
#include <cstdio>
#include <cstdint>
namespace cg = cooperative_groups;


#ifndef DUP_MASK
#define DUP_MASK 0u
#endif
#define GAS __attribute__((address_space(1)))
#define LAS __attribute__((address_space(3)))
typedef unsigned short bf16;
typedef unsigned v4u __attribute__((ext_vector_type(4)));
typedef unsigned v2u __attribute__((ext_vector_type(2)));
typedef float f32x4 __attribute__((ext_vector_type(4)));
typedef float f32x2 __attribute__((ext_vector_type(2)));
typedef short bf16x8 __attribute__((ext_vector_type(8)));

constexpr int DM = 1024, TOK = 8192, NPROMPT = 4096, DFF = 2816, DRNN = 1280;
constexpr int GLA_N = 3104, GLA_NP = 3328, PROJ_LD = 3072;
constexpr float EPS = 1e-6f;
constexpr size_t OUT_RG = (size_t)TOK * DM, OUT_GLA = OUT_RG + 16 * 2 * 1280;

constexpr size_t MiB = 1u << 20;
constexpr size_t WS_MOD = MiB / 2;
constexpr size_t WS_WFI = 1 * MiB;
constexpr size_t WS_WFO = 45 * MiB;
constexpr size_t WS_WRI = 67 * MiB;
constexpr size_t WS_WRO = 72 * MiB;
constexpr size_t WS_WGI = 75 * MiB;
constexpr size_t WS_WGO = 82 * MiB;
constexpr size_t WS_WGT = 84 * MiB;
constexpr size_t WS_XN  = 86 * MiB;
constexpr size_t WS_P   = 102 * MiB;
constexpr size_t WS_HID = 166 * MiB;
constexpr size_t WS_MIX = 210 * MiB;
constexpr size_t WS_Z   = WS_MIX + 48 * MiB;
constexpr size_t WS_PG  = 230 * MiB;
constexpr size_t WS_SEG = 259 * MiB;
constexpr size_t WS_QF = 166 * MiB, WS_KF = 182 * MiB, WS_DEC = 198 * MiB, WS_PF = 199 * MiB;
constexpr size_t WS_VF = 260 * MiB;
constexpr size_t WS_END = 276 * MiB;

typedef __bf16 bf16x2_t __attribute__((ext_vector_type(2)));
__device__ __forceinline__ unsigned cvt_pk_bf16(float lo, float hi) { f32x2 v = {lo, hi}; bf16x2_t b = __builtin_convertvector(v, bf16x2_t); return __builtin_bit_cast(unsigned, b); }
__device__ __forceinline__ float bf2f(unsigned short b) { return __uint_as_float(((unsigned)b) << 16); }
__device__ __forceinline__ float bflo(unsigned u) { return __uint_as_float(u << 16); }
__device__ __forceinline__ float bfhi(unsigned u) { return __uint_as_float(u & 0xffff0000u); }
__device__ __forceinline__ float fast_sigmoid(float x) { return __builtin_amdgcn_rcpf(1.0f + __expf(-x)); }
__device__ __forceinline__ float silu_f(float x) { return x * fast_sigmoid(x); }
__device__ __forceinline__ float gelu_tanh_f(float x) { return x * fast_sigmoid(1.5957691216057308f * (x + 0.044715f * x * x * x)); }
__device__ __forceinline__ float dpp_add(float v, const int ctrl_sel) {
    int r;
    switch (ctrl_sel) {
        case 0:  r = __builtin_amdgcn_update_dpp(0, __builtin_bit_cast(int, v), 0xB1, 0xF, 0xF, true); break;
        case 1:  r = __builtin_amdgcn_update_dpp(0, __builtin_bit_cast(int, v), 0x4E, 0xF, 0xF, true); break;
        case 2:  r = __builtin_amdgcn_update_dpp(0, __builtin_bit_cast(int, v), 0x141, 0xF, 0xF, true); break;
        default: r = __builtin_amdgcn_update_dpp(0, __builtin_bit_cast(int, v), 0x140, 0xF, 0xF, true); break;
    }
    return v + __builtin_bit_cast(float, r);
}
__device__ __forceinline__ float wave_sum(float v) {
    v = dpp_add(v, 0); v = dpp_add(v, 1); v = dpp_add(v, 2); v = dpp_add(v, 3);
    const int iv = __builtin_bit_cast(int, v);
    const float r0 = __builtin_bit_cast(float, __builtin_amdgcn_readlane(iv, 0)), r1 = __builtin_bit_cast(float, __builtin_amdgcn_readlane(iv, 16));
    const float r2 = __builtin_bit_cast(float, __builtin_amdgcn_readlane(iv, 32)), r3 = __builtin_bit_cast(float, __builtin_amdgcn_readlane(iv, 48));
    return (r0 + r1) + (r2 + r3);
}
#define LDS_BAR() do { asm volatile("s_waitcnt lgkmcnt(0)" ::: "memory"); __builtin_amdgcn_s_barrier(); asm volatile("" ::: "memory"); } while (0)
namespace pg8 {
#define PG8_LAS __attribute__((address_space(3)))
typedef unsigned short bf16_t;
constexpr int BM = 256, BK = 64, HALF = 128, HTB = HALF * BK * 2, STAGE_BYTES = 8 * HTB, NXCD = 8, WGM = 4;

__host__ __device__ __forceinline__ int lds_byte(int r, int c) { const int st = (r >> 4) * 2 + (c >> 5), rr = r & 15, cc = c & 31, ob = rr * 64 + cc * 2; return st * 1024 + (ob ^ (((ob >> 9) & 1) << 5)); }
__host__ __device__ __forceinline__ void stage_rc(int b, int& R, int& C) { const int st = b / 1024, sb = b % 1024, swz = sb ^ (((sb >> 9) & 1) << 5); R = (st >> 1) * 16 + swz / 64; C = (st & 1) * 32 + (swz % 64) / 2; }
__host__ __device__ __forceinline__ int perm32(int rho) { const int n = rho >> 4, i = rho & 15; return 8 * (i >> 2) + 4 * n + (i & 3); }

struct Unit { int pm, pn, ks; };
struct Gemm { const bf16_t* A; const bf16_t* Bt; int K, lda, ldb, ksA, ksB; };

struct Order {
    int nM, nNv, nNr, nwg, G, c;
    __device__ void init(int M, int Nreal, int nsplit, int G_, int c_) { nM = M / BM; nNr = Nreal / BM; nNv = nNr * nsplit; nwg = nM * nNv; G = G_; c = c_; }
    __device__ bool next(int i, Unit& u) const {
        const long L = (long)i * G + c; if (L >= nwg) return false;
        int wgid = (int)L; { const int q = nwg / NXCD, r = nwg % NXCD, xcd = wgid % NXCD, off = wgid / NXCD; wgid = (xcd < r ? xcd * (q + 1) : r * (q + 1) + (xcd - r) * q) + off; }
        const int nig = WGM * nNv, gid = wgid / nig, fm = gid * WGM, gsz = (nM - fm) < WGM ? (nM - fm) : WGM;
        u.pm = fm + ((wgid % nig) % gsz); const int pv = (wgid % nig) / gsz; u.pn = pv % nNr; u.ks = pv / nNr; return true;
    }
};

template <class Epi>
__device__ __forceinline__ void gemm_phase(PG8_LAS unsigned char* lds, const Gemm g, const Order& S, const Epi& E) {
    const int tid = threadIdx.x, wid = __builtin_amdgcn_readfirstlane(tid >> 6), lane = tid & 63, wr = wid >> 2, wc = wid & 3, fr = lane & 15, fq = lane >> 4;
    const int K = g.K, nt = K / BK;
    unsigned voffA[2], voffB[2];
#pragma unroll
    for (int i = 0; i < 2; ++i) { int R, C; stage_rc(tid * 16 + i * 8192, R, C); const int Rb = Epi::PERM ? ((R & ~31) + perm32(R & 31)) : R;
        voffA[i] = (unsigned)(R * g.lda + C) * 2u; voffB[i] = (unsigned)(Rb * g.ldb + C) * 2u; }
    const size_t kstep = (size_t)(BK * 2);
    const size_t hstepA = (size_t)HALF * g.lda * 2, hstepB = (size_t)HALF * g.ldb * 2;
    const unsigned ldsw = (unsigned)wid * 1024u;
    const int aoff = lds_byte(wr * 64 + fr, fq * 8), boff = lds_byte(wc * 32 + fr, fq * 8);
#define PG8_SA(b, h) (((b) * 2 + (h)) * HTB)
#define PG8_SB(b, h) ((4 + (b) * 2 + (h)) * HTB)
#define PG8_STAGE(bufoff, gbase, voff) do { _Pragma("unroll") for (int _i = 0; _i < 2; ++_i) \
        __builtin_amdgcn_global_load_lds((const unsigned*)((const char*)(gbase) + (voff)[_i]), (PG8_LAS unsigned*)(lds + (bufoff) + ldsw + _i * 8192), 16, 0, 0); } while (0)
#define PG8_LDA(dst, b, h) do { _Pragma("unroll") for (int m = 0; m < 4; ++m) _Pragma("unroll") for (int k = 0; k < 2; ++k) dst[m][k] = *(const PG8_LAS bf16x8*)(lds + PG8_SA(b, h) + aoff + m * 2048 + k * 1024); } while (0)
#define PG8_LDB(dst, b, h) do { _Pragma("unroll") for (int n = 0; n < 2; ++n) _Pragma("unroll") for (int k = 0; k < 2; ++k) dst[n][k] = *(const PG8_LAS bf16x8*)(lds + PG8_SB(b, h) + boff + n * 2048 + k * 1024); } while (0)
#define PG8_MMA(ai, bj, At, Bt) do { __builtin_amdgcn_s_setprio(1); _Pragma("unroll") for (int m = 0; m < 4; ++m) _Pragma("unroll") for (int n = 0; n < 2; ++n) _Pragma("unroll") for (int k = 0; k < 2; ++k) \
        acc[ai][bj][m][n] = __builtin_amdgcn_mfma_f32_16x16x32_bf16(Bt[n][k], At[m][k], acc[ai][bj][m][n], 0, 0, 0); __builtin_amdgcn_s_setprio(0); } while (0)
#define PG8_WAIT_V(n) asm volatile("s_waitcnt vmcnt(" #n ")" ::: "memory")
#define PG8_WAIT_L(n) asm volatile("s_waitcnt lgkmcnt(" #n ")" ::: "memory")
#define PG8_BAR __builtin_amdgcn_s_barrier()
#define PG8_SCHED __builtin_amdgcn_sched_barrier(0)
#define PG8_UA(u) ((const char*)g.A + (size_t)(u).pm * 2 * hstepA + (size_t)(u).ks * g.ksA * 2)
#define PG8_UB(u) ((const char*)g.Bt + (size_t)(u).pn * 2 * hstepB + (size_t)(u).ks * g.ksB * 2)
    Unit cur, nxt; int ui = 0;
    if (!S.next(0, cur)) return;
    f32x4 acc[2][2][4][2];
#pragma unroll
    for (int a = 0; a < 2; ++a)
#pragma unroll
        for (int b = 0; b < 2; ++b)
#pragma unroll
            for (int m = 0; m < 4; ++m)
#pragma unroll
                for (int n = 0; n < 2; ++n) acc[a][b][m][n] = (f32x4){0.f, 0.f, 0.f, 0.f};
    bf16x8 At[4][2], B0[2][2], B1[2][2];
    const char* cA = PG8_UA(cur); const char* cB = PG8_UB(cur);
    PG8_STAGE(PG8_SB(0, 0), cB, voffB); PG8_STAGE(PG8_SB(0, 1), cB + hstepB, voffB); PG8_STAGE(PG8_SA(0, 0), cA, voffA); PG8_STAGE(PG8_SA(0, 1), cA + hstepA, voffA);
    if (wr == 1) PG8_BAR;
    PG8_WAIT_V(2); PG8_BAR;
    PG8_STAGE(PG8_SB(1, 0), cB + kstep, voffB); PG8_STAGE(PG8_SA(1, 0), cA + kstep, voffA); PG8_STAGE(PG8_SB(1, 1), cB + hstepB + kstep, voffB);
    PG8_WAIT_V(6); PG8_BAR;
    for (;;) {
        const bool has_next = S.next(ui + 1, nxt);
        const char* nA = has_next ? PG8_UA(nxt) : cA; const char* nB = has_next ? PG8_UB(nxt) : cB;
        for (int t = 0; t < nt; t += 2) {
            const bool last = (t == nt - 2);
            const char* a1 = cA + (size_t)(t + 1) * kstep;
            const char* a2 = last ? nA : cA + (size_t)(t + 2) * kstep; const char* b2 = last ? nB : cB + (size_t)(t + 2) * kstep;
            const char* a3 = a2 + kstep; const char* b3 = b2 + kstep;
            PG8_LDB(B0, 0, 0); PG8_LDB(B1, 0, 1); PG8_SCHED; PG8_LDA(At, 0, 0); PG8_STAGE(PG8_SA(1, 1), a1 + hstepA, voffA);
            PG8_WAIT_V(8); PG8_WAIT_L(0); PG8_BAR; PG8_MMA(0, 0, At, B0); PG8_MMA(0, 1, At, B1); PG8_BAR; PG8_SCHED;
            PG8_LDA(At, 0, 1); PG8_STAGE(PG8_SB(0, 0), b2, voffB); PG8_STAGE(PG8_SB(0, 1), b2 + hstepB, voffB); PG8_STAGE(PG8_SA(0, 0), a2, voffA);
            PG8_WAIT_V(8); PG8_WAIT_L(0); PG8_BAR; PG8_MMA(1, 0, At, B0); PG8_MMA(1, 1, At, B1); PG8_BAR; PG8_SCHED;
            PG8_LDB(B0, 1, 0); PG8_LDB(B1, 1, 1); PG8_SCHED; PG8_LDA(At, 1, 0); PG8_STAGE(PG8_SA(0, 1), a2 + hstepA, voffA);
            PG8_WAIT_V(8); PG8_WAIT_L(0); PG8_BAR; PG8_MMA(0, 0, At, B0); PG8_MMA(0, 1, At, B1); PG8_BAR; PG8_SCHED;
            PG8_LDA(At, 1, 1); PG8_STAGE(PG8_SB(1, 0), b3, voffB); PG8_STAGE(PG8_SB(1, 1), b3 + hstepB, voffB); PG8_STAGE(PG8_SA(1, 0), a3, voffA);
            PG8_WAIT_V(8); PG8_WAIT_L(0); PG8_BAR; PG8_MMA(1, 0, At, B0); PG8_MMA(1, 1, At, B1); PG8_BAR; PG8_SCHED;
        }
        if (wr == 0) PG8_BAR;
        E(acc, cur, wr, wc, fr, fq);
        if (!has_next) break;
#pragma unroll
        for (int a = 0; a < 2; ++a)
#pragma unroll
            for (int b = 0; b < 2; ++b)
#pragma unroll
                for (int m = 0; m < 4; ++m)
#pragma unroll
                    for (int n = 0; n < 2; ++n) acc[a][b][m][n] = (f32x4){0.f, 0.f, 0.f, 0.f};
        cur = nxt; cA = nA; cB = nB; ++ui;
        if (wr == 1) PG8_BAR;
    }
    PG8_WAIT_V(0);
    PG8_BAR;
#undef PG8_SA
#undef PG8_SB
#undef PG8_STAGE
#undef PG8_LDA
#undef PG8_LDB
#undef PG8_MMA
#undef PG8_WAIT_V
#undef PG8_WAIT_L
#undef PG8_BAR
#undef PG8_SCHED
#undef PG8_UA
#undef PG8_UB
}

struct EpiSwiglu {
    static constexpr bool PERM = true;
    bf16_t* H;
    __device__ __forceinline__ void operator()(const f32x4 (&acc)[2][2][4][2], const Unit& u, int wr, int wc, int fr, int fq) const {
        const int row0 = u.pm * BM + wr * 64 + fr, colh = u.pn * 128 + wc * 32 + 8 * fq;
#pragma unroll
        for (int ai = 0; ai < 2; ++ai)
#pragma unroll
            for (int m = 0; m < 4; ++m) {
                const f32x4 g0 = acc[ai][0][m][0], g1 = acc[ai][0][m][1], u0 = acc[ai][1][m][0], u1 = acc[ai][1][m][1];
                v4u w;
                w.x = cvt_pk_bf16(silu_f(g0[0]) * u0[0], silu_f(g0[1]) * u0[1]); w.y = cvt_pk_bf16(silu_f(g0[2]) * u0[2], silu_f(g0[3]) * u0[3]);
                w.z = cvt_pk_bf16(silu_f(g1[0]) * u1[0], silu_f(g1[1]) * u1[1]); w.w = cvt_pk_bf16(silu_f(g1[2]) * u1[2], silu_f(g1[3]) * u1[3]);
                *(v4u*)(H + (size_t)(row0 + ai * HALF + m * 16) * DFF + colh) = w;
            }
    }
};
struct EpiPart {
    static constexpr bool PERM = true;
    bf16_t* P;
    __device__ __forceinline__ void operator()(const f32x4 (&acc)[2][2][4][2], const Unit& u, int wr, int wc, int fr, int fq) const {
        bf16_t* base = P + (size_t)u.ks * TOK * DM + (size_t)(u.pm * BM + wr * 64 + fr) * DM + u.pn * BM + wc * 32 + 8 * fq;
#pragma unroll
        for (int ai = 0; ai < 2; ++ai)
#pragma unroll
            for (int m = 0; m < 4; ++m)
#pragma unroll
                for (int bj = 0; bj < 2; ++bj) { const f32x4 a = acc[ai][bj][m][0], b = acc[ai][bj][m][1];
                    *(v4u*)(base + (size_t)(ai * HALF + m * 16) * DM + bj * HALF) = (v4u){cvt_pk_bf16(a[0], a[1]), cvt_pk_bf16(a[2], a[3]), cvt_pk_bf16(b[0], b[1]), cvt_pk_bf16(b[2], b[3])}; }
    }
};
struct EpiRgIn {
    static constexpr bool PERM = true;
    bf16_t* GG; bf16_t* XBR;
    __device__ __forceinline__ void operator()(const f32x4 (&acc)[2][2][4][2], const Unit& u, int wr, int wc, int fr, int fq) const {
        const int row0 = u.pm * BM + wr * 64 + fr;
        if (u.pn < 5) {
            const int col0 = u.pn * BM + wc * 32 + 8 * fq;
#pragma unroll
            for (int ai = 0; ai < 2; ++ai)
#pragma unroll
                for (int m = 0; m < 4; ++m)
#pragma unroll
                    for (int bj = 0; bj < 2; ++bj) {
                        const f32x4 a = acc[ai][bj][m][0], b = acc[ai][bj][m][1]; v4u w;
                        w.x = cvt_pk_bf16(gelu_tanh_f(a[0]), gelu_tanh_f(a[1])); w.y = cvt_pk_bf16(gelu_tanh_f(a[2]), gelu_tanh_f(a[3]));
                        w.z = cvt_pk_bf16(gelu_tanh_f(b[0]), gelu_tanh_f(b[1])); w.w = cvt_pk_bf16(gelu_tanh_f(b[2]), gelu_tanh_f(b[3]));
                        *(v4u*)(GG + (size_t)(row0 + ai * HALF + m * 16) * DRNN + col0 + bj * HALF) = w;
                    }
        } else {
            const int col0 = (u.pn - 5) * BM + wc * 32 + 8 * fq;
#pragma unroll
            for (int ai = 0; ai < 2; ++ai)
#pragma unroll
                for (int m = 0; m < 4; ++m)
#pragma unroll
                    for (int bj = 0; bj < 2; ++bj) {
                        const f32x4 a = acc[ai][bj][m][0], b = acc[ai][bj][m][1];
                        *(v4u*)(XBR + (size_t)(row0 + ai * HALF + m * 16) * DRNN + col0 + bj * HALF) = (v4u){cvt_pk_bf16(a[0], a[1]), cvt_pk_bf16(a[2], a[3]), cvt_pk_bf16(b[0], b[1]), cvt_pk_bf16(b[2], b[3])};
                    }
        }
    }
};
struct EpiGlaIn {
    static constexpr bool PERM = true;
    bf16_t* PROJ; float* Z;
    __device__ __forceinline__ void operator()(const f32x4 (&acc)[2][2][4][2], const Unit& u, int wr, int wc, int fr, int fq) const {
        const int row0 = u.pm * BM + wr * 64 + fr;
        if (u.pn < 12) {
            const int col0 = u.pn * BM + wc * 32 + 8 * fq;
            const float sc = (u.pn < 2) ? 0.08838834764831845f : 1.0f; const bool act = (u.pn >= 8);
#pragma unroll
            for (int ai = 0; ai < 2; ++ai)
#pragma unroll
                for (int m = 0; m < 4; ++m)
#pragma unroll
                    for (int bj = 0; bj < 2; ++bj) {
                        f32x4 a = acc[ai][bj][m][0] * sc, b = acc[ai][bj][m][1] * sc;
                        if (act) { a = (f32x4){silu_f(a[0]), silu_f(a[1]), silu_f(a[2]), silu_f(a[3])}; b = (f32x4){silu_f(b[0]), silu_f(b[1]), silu_f(b[2]), silu_f(b[3])}; }
                        v4u w; w.x = cvt_pk_bf16(a[0], a[1]); w.y = cvt_pk_bf16(a[2], a[3]); w.z = cvt_pk_bf16(b[0], b[1]); w.w = cvt_pk_bf16(b[2], b[3]);
                        *(v4u*)(PROJ + (size_t)(row0 + ai * HALF + m * 16) * PROJ_LD + col0 + bj * HALF) = w;
                    }
        } else if (wc == 0) {
#pragma unroll
            for (int ai = 0; ai < 2; ++ai)
#pragma unroll
                for (int m = 0; m < 4; ++m) {
                    float* p = Z + (size_t)(row0 + ai * HALF + m * 16) * 32 + 8 * fq;
                    *(f32x4*)p = acc[ai][0][m][0]; *(f32x4*)(p + 4) = acc[ai][0][m][1];
                }
        }
    }
};
}

struct Args { const float* in[26]; float* out; unsigned char* ws; int ph_lo, ph_hi; };
enum { I_XP = 0, I_XS, I_C, I_SRG, I_SGLA, I_CCTX, I_ADAW, I_ADAB, I_NORMG, I_FWI, I_FWO, I_RWI, I_RCW, I_RCB, I_RWA, I_RBA, I_RWIG, I_RBI, I_RLAM, I_RWO,
       I_GWI, I_GW2, I_GBG, I_GNORM, I_GWO, I_FNORM };

__device__ __forceinline__ void transpose_item(const float* W, int N, int k0, int n0, bf16* dst, int ldk, LAS float* scr, int lane) {
    float tv[32];
#pragma unroll
    for (int i = 0; i < 32; ++i) tv[i] = __builtin_nontemporal_load(&W[(size_t)(k0 + 2 * i + (lane >> 5)) * N + n0 + (lane & 31)]);
#pragma unroll
    for (int i = 0; i < 32; ++i) scr[(2 * i + (lane >> 5)) * 33 + (lane & 31)] = tv[i];
    asm volatile("s_waitcnt lgkmcnt(0)" ::: "memory");
    const int c = lane & 7;
#pragma unroll
    for (int j = 0; j < 4; ++j) { const int n = (lane >> 3) + 8 * j; const LAS float* s = scr + (8 * c) * 33 + n;
        v4u o; o.x = cvt_pk_bf16(s[0 * 33], s[1 * 33]); o.y = cvt_pk_bf16(s[2 * 33], s[3 * 33]); o.z = cvt_pk_bf16(s[4 * 33], s[5 * 33]); o.w = cvt_pk_bf16(s[6 * 33], s[7 * 33]);
        *(v4u*)(dst + (size_t)n * ldk + k0 + 8 * c) = o; }
    asm volatile("s_waitcnt lgkmcnt(0)" ::: "memory");
}

__device__ __forceinline__ void ada_items(const Args& a, LAS unsigned char* lds, const int first, const int stride, const int limit) {
    const int tid = threadIdx.x, lane = tid & 63, wave = tid >> 6;
    if (first >= limit) return;
    LAS float* sv = (LAS float*)lds;
    LAS float* red = (LAS float*)(lds + 12288);
    for (int i = tid; i < 3 * 1024; i += 512) { const int g = i >> 10, k = i & 1023; const float v = (g == 0) ? a.in[I_CCTX][k] : a.in[I_C][(g - 1) * 1024 + k]; sv[i] = silu_f(v); }
    __syncthreads();
    float* mod = (float*)(a.ws + WS_MOD);
    for (int it = first; it < limit; it += stride) {
        const int l = it / 144, n0 = (it % 144) * 64;
        const float* W = a.in[I_ADAW] + (size_t)l * 1024 * 9216 + n0 + lane;
        float a0 = 0.f, a1 = 0.f, a2 = 0.f;
        const int kb = wave * 128;
#pragma unroll 16
        for (int k = 0; k < 128; ++k) { const float wv = __builtin_nontemporal_load(&W[(size_t)(kb + k) * 9216]); a0 += sv[kb + k] * wv; a1 += sv[1024 + kb + k] * wv; a2 += sv[2048 + kb + k] * wv; }
        red[(wave * 3 + 0) * 64 + lane] = a0; red[(wave * 3 + 1) * 64 + lane] = a1; red[(wave * 3 + 2) * 64 + lane] = a2;
        __syncthreads();
        if (tid < 192) { const int g = tid >> 6, c = tid & 63; float sm = a.in[I_ADAB][l * 9216 + n0 + c];
#pragma unroll
            for (int w = 0; w < 8; ++w) sm += red[(w * 3 + g) * 64 + c];
            mod[(size_t)(l * 3 + g) * 9216 + n0 + c] = sm; }
        __syncthreads();
    }
}

__device__ __forceinline__ void convert_weights(const Args& a, LAS unsigned char* lds, const int group, const int first, const int step, const int end, const int gw, const int NGW) {
    const int lane = threadIdx.x & 63, wave = threadIdx.x >> 6;
    unsigned char* ws = a.ws;
    LAS float* scr = (LAS float*)(lds + wave * 16384);
    constexpr int I_FI = 16 * 176, I_FO = 44 * 32, I_RI = 16 * 80, I_RO = 20 * 32, I_GI = 16 * 97, I_GO = 16 * 32, I_GT = 8;
    const int mi0 = (group == 0) ? 0 : group + 1, nmi = (group == 0) ? 2 : 1;
    const int n_ri = (group == 0) ? I_RI : 0, n_ro = (group == 0) ? I_RO : 0, n_gt = (group == 0) ? 40 * I_GT : 0;
    const int n_gi = (group == 1) ? I_GI : 0, n_go = (group == 1) ? I_GO : 0;
    const int nitems = nmi * (I_FI + I_FO) + n_ri + n_ro + n_gi + n_go + n_gt;
    const int stop = end < nitems ? end : nitems;
    for (int it = first; it < stop; it += step) {
        int r = it;
        if (r < nmi * I_FI) { const int mi = mi0 + r / I_FI; r %= I_FI; const int kb = r / 176, n0 = (r % 176) * 32;
            const int drow = (n0 < DFF) ? (n0 / 128) * 256 + (n0 % 128) : ((n0 - DFF) / 128) * 256 + 128 + ((n0 - DFF) % 128);
            transpose_item(a.in[I_FWI] + (size_t)mi * 1024 * 5632, 5632, kb * 64, n0, (bf16*)(ws + WS_WFI) + ((size_t)mi * 5632 + drow) * 1024, 1024, scr, lane); continue; }
        r -= nmi * I_FI;
        if (r < nmi * I_FO) { const int mi = mi0 + r / I_FO; r %= I_FO; const int kb = r / 32, n0 = (r % 32) * 32;
            transpose_item(a.in[I_FWO] + (size_t)mi * 2816 * 1024, 1024, kb * 64, n0, (bf16*)(ws + WS_WFO) + ((size_t)mi * 1024 + n0) * 2816, 2816, scr, lane); continue; }
        r -= nmi * I_FO;
        if (r < n_ri) { const int kb = r / 80, n0 = (r % 80) * 32;
            transpose_item(a.in[I_RWI], 2560, kb * 64, n0, (bf16*)(ws + WS_WRI) + (size_t)n0 * 1024, 1024, scr, lane); continue; }
        r -= n_ri;
        if (r < n_ro) { const int kb = r / 32, n0 = (r % 32) * 32;
            transpose_item(a.in[I_RWO], 1024, kb * 64, n0, (bf16*)(ws + WS_WRO) + (size_t)n0 * 1280, 1280, scr, lane); continue; }
        r -= n_ro;
        if (r < n_gi) { const int kb = r / 97, n0 = (r % 97) * 32;
            transpose_item(a.in[I_GWI], GLA_N, kb * 64, n0, (bf16*)(ws + WS_WGI) + (size_t)n0 * 1024, 1024, scr, lane); continue; }
        r -= n_gi;
        if (r < n_go) { const int kb = r / 32, n0 = (r % 32) * 32;
            transpose_item(a.in[I_GWO], 1024, kb * 64, n0, (bf16*)(ws + WS_WGO) + (size_t)n0 * 1024, 1024, scr, lane); continue; }
        r -= n_go;
        { const int mi = r / I_GT; r %= I_GT; const int kb = r / 4, n0 = (r % 4) * 32;
          const int which = mi / 20, dn = mi % 20;
          const float* src = (which ? a.in[I_RWIG] : a.in[I_RWA]) + (size_t)dn * 128 * 128;
          transpose_item(src, 128, kb * 64, n0, (bf16*)(ws + WS_WGT) + ((size_t)dn * 256 + which * 128 + n0) * 128, 128, scr, lane); }
    }
    if (group == 1) {
        v4u* z = (v4u*)((bf16*)(ws + WS_WGI) + (size_t)GLA_N * 1024);
        const int nz = (GLA_NP - GLA_N) * 1024 * 2 / 16;
        for (int i = gw * 64 + lane; i < nz; i += NGW * 64) z[i] = (v4u){0u, 0u, 0u, 0u};
    }
}

__device__ __forceinline__ void phase_prep(const Args& a, LAS unsigned char* lds) {
    const int tid = threadIdx.x, lane = tid & 63, wave = tid >> 6;
    unsigned char* ws = a.ws;
    ada_items(a, lds, (int)blockIdx.x, (int)gridDim.x, (gridDim.x == 256) ? 144 : 288);
    __syncthreads();
    {
        const int gw = blockIdx.x * 8 + wave, NGW = gridDim.x * 8;
        if (gridDim.x == 256) {
            constexpr int N0 = 2 * (16 * 176) + 2 * (44 * 32) + 16 * 80 + 20 * 32 + 40 * 8, WTOT = 144 * 73 + 112 * 100;
            const int b = blockIdx.x;
            const int cw0 = (b < 144) ? 73 * b : 144 * 73 + 100 * (b - 144), cw1 = (b + 1 <= 144) ? 73 * (b + 1) : 144 * 73 + 100 * (b + 1 - 144);
            const int st = (int)(((long)N0 * cw0) / WTOT), en = (int)(((long)N0 * cw1) / WTOT);
            convert_weights(a, lds, 0, st + wave, 8, en, gw, NGW);
        } else {
            convert_weights(a, lds, 0, gw, NGW, 0x7fffffff, gw, NGW); convert_weights(a, lds, 1, gw, NGW, 0x7fffffff, gw, NGW); convert_weights(a, lds, 2, gw, NGW, 0x7fffffff, gw, NGW);
        }
    }
}

__device__ __forceinline__ void phase_combine(const Args& a, int first, int fin, int lg, int jg, float coef, int ln, int jn) {
    const int tid = threadIdx.x, lane = tid & 63, wave = tid >> 6;
    const int gw = blockIdx.x * 8 + wave, NGW = gridDim.x * 8;
    float* X = a.out; const float* mod = (const float*)(a.ws + WS_MOD); const bf16* P = (const bf16*)(a.ws + WS_P); bf16* XN = (bf16*)(a.ws + WS_XN);
    const bool aff = (gridDim.x == 256);
    const int affm0 = 1024 * (blockIdx.x & 7) + 32 * (blockIdx.x >> 3) + 4 * wave;
    for (int m0 = aff ? affm0 : gw * 4; m0 < TOK; m0 += aff ? TOK : NGW * 4) {
        const int g = (m0 < NPROMPT) ? 0 : 1 + ((m0 - NPROMPT) >> 11);
        f32x4 cg[4], gs[4], sh[4];
#pragma unroll
        for (int j = 0; j < 4; ++j) {
            cg[j] = first ? (f32x4){0.f, 0.f, 0.f, 0.f} : coef * ((const f32x4*)(mod + (size_t)((lg * 3 + g) * 9 + 3 * jg + 2) * DM))[lane + 64 * j];
            if (fin) { gs[j] = ((const f32x4*)a.in[I_FNORM])[lane + 64 * j]; sh[j] = (f32x4){0.f, 0.f, 0.f, 0.f}; }
            else { gs[j] = ((const f32x4*)(a.in[I_NORMG] + (size_t)(ln * 3 + jn) * DM))[lane + 64 * j] * (1.0f + ((const f32x4*)(mod + (size_t)((ln * 3 + g) * 9 + 3 * jn + 1) * DM))[lane + 64 * j]);
                   sh[j] = ((const f32x4*)(mod + (size_t)((ln * 3 + g) * 9 + 3 * jn) * DM))[lane + 64 * j]; }
        }
#pragma unroll
        for (int r = 0; r < 4; ++r) {
            const int m = m0 + r;
            const float* xs = first ? ((m < NPROMPT) ? a.in[I_XP] + (size_t)m * DM : a.in[I_XS] + (size_t)(m - NPROMPT) * DM) : X + (size_t)m * DM;
            f32x4 v[4];
#pragma unroll
            for (int j = 0; j < 4; ++j) v[j] = first ? __builtin_nontemporal_load(&((const f32x4*)xs)[lane + 64 * j]) : ((const f32x4*)xs)[lane + 64 * j];
            if (!first) {
                const v2u* p0 = (const v2u*)(P + (size_t)m * DM); const v2u* p1 = (const v2u*)(P + (size_t)TOK * DM + (size_t)m * DM);
#pragma unroll
                for (int j = 0; j < 4; ++j) { const v2u a0 = p0[lane + 64 * j], a1 = p1[lane + 64 * j];
                    const f32x4 ps = (f32x4){bflo(a0.x) + bflo(a1.x), bfhi(a0.x) + bfhi(a1.x), bflo(a0.y) + bflo(a1.y), bfhi(a0.y) + bfhi(a1.y)};
                    v[j] += cg[j] * ps; }
            }
            float ss = 0.f;
#pragma unroll
            for (int j = 0; j < 4; ++j) ss += (v[j][0] * v[j][0] + v[j][1] * v[j][1]) + (v[j][2] * v[j][2] + v[j][3] * v[j][3]);
            const float rstd = 1.0f / sqrtf(wave_sum(ss) * (1.0f / DM) + EPS);
            if (fin) {
#pragma unroll
                for (int j = 0; j < 4; ++j) ((f32x4*)(X + (size_t)m * DM))[lane + 64 * j] = v[j] * rstd * gs[j];
            } else {
#pragma unroll
                for (int j = 0; j < 4; ++j) {
                    ((f32x4*)(X + (size_t)m * DM))[lane + 64 * j] = v[j];
                    const f32x4 y = (v[j] * rstd) * gs[j] + sh[j];
                    v2u w; w.x = cvt_pk_bf16(y[0], y[1]); w.y = cvt_pk_bf16(y[2], y[3]);
                    ((v2u*)(XN + (size_t)m * DM))[lane + 64 * j] = w;
                }
            }
        }
    }
}

__device__ __forceinline__ void phase_rg(const Args& a, LAS unsigned char* lds) {
    const int tid = threadIdx.x, lane = tid & 63, w = __builtin_amdgcn_readfirstlane(tid >> 6), l15 = lane & 15, lq = lane >> 4;
    unsigned char* ws = a.ws;
    const bf16* XBR = (const bf16*)(ws + WS_P);
    const bf16* GG = (const bf16*)(ws + WS_MIX);
    bf16* Y2 = (bf16*)(ws + WS_HID);
    bf16* PG = (bf16*)(ws + WS_PG);
    const bf16* WG = (const bf16*)(ws + WS_WGT);
    f32x2* SEG = (f32x2*)(ws + WS_SEG);
    LAS float* XCF = (LAS float*)lds;
    LAS unsigned short* XA = (LAS unsigned short*)(lds + 32768);
    LAS f32x2* AU = (LAS f32x2*)(lds + 50176);
    const int cc = tid & 127, tg = w >> 1;
    const int nitems = 320 + 640;
    const bool deal = (gridDim.x == 256);
    for (int kk = 0;; ++kk) {
        int it;
        if (deal) { const int b = blockIdx.x; if (kk > 3) break;
            if (kk == 0) it = b; else if (kk == 1) it = (b < 64) ? 256 + b : 320 + (b - 64); else if (kk == 2) it = 320 + 192 + b; else { if (b < 64) break; it = 320 + 448 + (b - 64); } }
        else { it = blockIdx.x + kk * gridDim.x; if (it >= nitems) break; }
        int s, r, pseg = 0, sb = 0;
        if (it < 320) { s = it / 20; r = it % 20; }
        else { const int q = it - 320; sb = q / 320; const int q2 = q % 320; pseg = q2 / 20; r = q2 % 20; s = 16 + sb; }
        const bool fix = (s >= 16 && pseg >= 1);
        const int n = r >> 1, d = r & 1;
        const int T = (s < 16) ? 256 : 2048, mb = (s < 16) ? s * 256 : NPROMPT + (s - 16) * 2048;
        const int ti0 = (s < 16) ? 0 : 2 * pseg, ti1 = (s < 16) ? 4 : 2 * pseg + 2;
        bf16x8 bfr[2][4];
        { const bf16* wg = WG + (size_t)((d * 10 + n) * 256) * 128;
#pragma unroll
          for (int f = 0; f < 2; ++f)
#pragma unroll
              for (int ks = 0; ks < 4; ++ks) bfr[f][ks] = *(const bf16x8*)(wg + (size_t)(f * 128 + 16 * w + l15) * 128 + 32 * ks + 8 * lq); }
        const int ch = 16 * w + l15, C = n * 128 + ch;
        const float ba = a.in[I_RBA][d * DRNN + C], bi = a.in[I_RBI][d * DRNN + C];
        float sp8; { const float nl = -a.in[I_RLAM][d * DRNN + C]; sp8 = 8.0f * (fmaxf(nl, 0.f) + log1pf(__expf(-fabsf(nl)))); }
        const int Cc = n * 128 + cc;
        const float w0 = a.in[I_RCW][Cc], w1 = a.in[I_RCW][DRNN + Cc], w2 = a.in[I_RCW][2 * DRNN + Cc], w3 = a.in[I_RCW][3 * DRNN + Cc], cb = a.in[I_RCB][Cc];
        float h = 0.f, pprod = 1.f;
        if (tid < 128 && s >= 16 && pseg == 0) h = a.in[I_SRG][((s - 16) * 2 + d) * DRNN + n * 128 + tid];
        unsigned xr[19]; unsigned ggp[8]; unsigned xm = 0u;
#pragma unroll
        for (int p = 0; p < 8; ++p) ggp[p] = 0u;
#define RG_LOAD(ti_) do { const int t0_ = d ? T - 64 * ((ti_) + 1) : 64 * (ti_); const int ts_ = t0_ + 16 * tg - 1; \
        const bf16* xp_ = XBR + (long)(mb + ts_) * DRNN + Cc; xm = 0u; \
        _Pragma("unroll") for (int i = 0; i < 19; ++i) { xr[i] = (unsigned)xp_[i * DRNN]; xm |= ((unsigned)(ts_ + i) < (unsigned)T) ? (1u << i) : 0u; } \
        const bf16* gp_ = GG + (size_t)(mb + t0_ + w) * DRNN + n * 128 + lane * 2; \
        _Pragma("unroll") for (int p = 0; p < 8; ++p) ggp[p] = *(const unsigned*)(gp_ + (size_t)(8 * p) * DRNN); } while (0)
        RG_LOAD(ti0);
        for (int ti = ti0; ti < ti1; ++ti) {
            const int t0 = d ? T - 64 * (ti + 1) : 64 * ti;
            float xv[19];
#pragma unroll
            for (int i = 0; i < 19; ++i) xv[i] = ((xm >> i) & 1u) ? __uint_as_float(xr[i] << 16) : 0.f;
#pragma unroll
            for (int i = 0; i < 16; ++i) { const float xc = cb + w0 * xv[i] + w1 * xv[i + 1] + w2 * xv[i + 2] + w3 * xv[i + 3];
                const int tl = 16 * tg + i; XCF[tl * 128 + cc] = xc; XA[tl * 136 + cc] = (unsigned short)(cvt_pk_bf16(xc, 0.f) & 0xffffu); }
            unsigned ggc[8];
#pragma unroll
            for (int p = 0; p < 8; ++p) ggc[p] = ggp[p];
            LDS_BAR();
            if (ti + 1 < ti1) RG_LOAD(ti + 1);
            f32x4 accA[4], accI[4]; float xcv[16];
#pragma unroll
            for (int mf = 0; mf < 4; ++mf) { accA[mf] = (f32x4){0.f, 0.f, 0.f, 0.f}; accI[mf] = (f32x4){0.f, 0.f, 0.f, 0.f}; }
#pragma unroll
            for (int e = 0; e < 16; ++e) xcv[e] = XCF[(16 * (e >> 2) + 4 * lq + (e & 3)) * 128 + ch];
#pragma unroll
            for (int ks = 0; ks < 4; ++ks)
#pragma unroll
                for (int mf = 0; mf < 4; ++mf) { const bf16x8 af = *(const LAS bf16x8*)(XA + (16 * mf + l15) * 136 + 32 * ks + 8 * lq);
                    accA[mf] = __builtin_amdgcn_mfma_f32_16x16x32_bf16(af, bfr[0][ks], accA[mf], 0, 0, 0);
                    accI[mf] = __builtin_amdgcn_mfma_f32_16x16x32_bf16(af, bfr[1][ks], accI[mf], 0, 0, 0); }
#pragma unroll
            for (int mf = 0; mf < 4; ++mf)
#pragma unroll
                for (int rg = 0; rg < 4; ++rg) { const int tl = 16 * mf + 4 * lq + rg;
                    const float rr = fast_sigmoid(accA[mf][rg] + ba), gi = fast_sigmoid(accI[mf][rg] + bi);
                    const float la = -sp8 * rr; const float av = __expf(la); const float uu = __builtin_amdgcn_sqrtf(fmaxf(1.0f - av * av, 0.f)) * gi * xcv[mf * 4 + rg];
                    AU[tl * 128 + ch] = (f32x2){av, uu}; }
            LDS_BAR();
            if (tid < 128) {
#pragma unroll 1
                for (int i0 = 0; i0 < 64; i0 += 8) {
                    f32x2 au[8];
#pragma unroll
                    for (int k = 0; k < 8; ++k) { const int tl = d ? 63 - (i0 + k) : i0 + k; au[k] = AU[tl * 128 + tid]; }
#pragma unroll
                    for (int k = 0; k < 8; ++k) { h = au[k].x * h + au[k].y; pprod *= au[k].x; au[k] = (f32x2){h, pprod}; }
#pragma unroll
                    for (int k = 0; k < 8; ++k) { const int tl = d ? 63 - (i0 + k) : i0 + k; AU[tl * 128 + tid] = au[k]; }
                }
            }
            LDS_BAR();
            f32x4 hp[8];
#pragma unroll
            for (int p = 0; p < 8; ++p) hp[p] = *(const LAS f32x4*)(AU + (8 * p + w) * 128 + lane * 2);
#pragma unroll
            for (int p = 0; p < 8; ++p) { const int tl = 8 * p + w, cp = lane * 2; const float g0 = bflo(ggc[p]), g1 = bfhi(ggc[p]);
                *(unsigned*)(Y2 + (size_t)(mb + t0 + tl) * (2 * DRNN) + d * DRNN + n * 128 + cp) = cvt_pk_bf16(hp[p][0] * g0, hp[p][2] * g1);
                if (fix) *(unsigned*)(PG + (size_t)(mb - NPROMPT + t0 + tl) * (2 * DRNN) + d * DRNN + n * 128 + cp) = cvt_pk_bf16(hp[p][1] * g0, hp[p][3] * g1); }
        }
        LDS_BAR();
#undef RG_LOAD
        if (tid < 128) {
            if (s < 16) a.out[OUT_RG + (size_t)(s * 2 + d) * DRNN + n * 128 + tid] = h;
            else SEG[(size_t)((sb * 16 + pseg) * 2 + d) * DRNN + n * 128 + tid] = (f32x2){pprod, h};
        }
    }
}

__device__ __forceinline__ void phase_rg_fix(const Args& a) {
    const int tid = threadIdx.x;
    unsigned char* ws = a.ws;
    bf16* Y2 = (bf16*)(ws + WS_HID); const bf16* PG = (const bf16*)(ws + WS_PG); const f32x2* SEG = (const f32x2*)(ws + WS_SEG);
    const int cp = (tid & 63) * 2, r8 = tid >> 6;
    for (int it = blockIdx.x; it < 640; it += gridDim.x) {
        const int n = it % 10, q = it / 10;
        const bool smp = q >= 32;
        const int sb = smp ? ((q - 32) >> 4) : 0, ts = smp ? ((q - 32) & 15) : 0;
        const int mb = smp ? NPROMPT + sb * 2048 + ts * 128 : q * 128;
        const int psf = smp ? ts : 0, psb = smp ? 15 - ts : 0;
        float hf0 = 0.f, hf1 = 0.f, hb0 = 0.f, hb1 = 0.f;
        if (smp) {
            f32x4 sf[15], sbk[15];
#pragma unroll
            for (int j = 0; j < 15; ++j) {
                sf[j]  = (j < psf) ? *(const f32x4*)(SEG + (size_t)((sb * 16 + j) * 2 + 0) * DRNN + n * 128 + cp) : (f32x4){1.f, 0.f, 1.f, 0.f};
                sbk[j] = (j < psb) ? *(const f32x4*)(SEG + (size_t)((sb * 16 + j) * 2 + 1) * DRNN + n * 128 + cp) : (f32x4){1.f, 0.f, 1.f, 0.f}; }
            hf0 = sf[0][1]; hf1 = sf[0][3]; hb0 = sbk[0][1]; hb1 = sbk[0][3];
#pragma unroll
            for (int j = 1; j < 15; ++j) { hf0 = sf[j][0] * hf0 + sf[j][1]; hf1 = sf[j][2] * hf1 + sf[j][3]; hb0 = sbk[j][0] * hb0 + sbk[j][1]; hb1 = sbk[j][2] * hb1 + sbk[j][3]; }
            if (psf == 0) { hf0 = 0.f; hf1 = 0.f; }
            if (psb == 0) { hb0 = 0.f; hb1 = 0.f; }
        }
        unsigned yf[16], yb[16], pf[16], pb[16];
#pragma unroll
        for (int i = 0; i < 16; ++i) { const size_t row = (size_t)(mb + 8 * i + r8);
            yf[i] = *(const unsigned*)(Y2 + row * (2 * DRNN) + n * 128 + cp); yb[i] = *(const unsigned*)(Y2 + row * (2 * DRNN) + DRNN + n * 128 + cp);
            pf[i] = (smp && psf >= 1) ? *(const unsigned*)(PG + (row - NPROMPT) * (2 * DRNN) + n * 128 + cp) : 0u;
            pb[i] = (smp && psb >= 1) ? *(const unsigned*)(PG + (row - NPROMPT) * (2 * DRNN) + DRNN + n * 128 + cp) : 0u; }
#pragma unroll
        for (int i = 0; i < 16; ++i) { const size_t row = (size_t)(mb + 8 * i + r8);
            const float s0 = (bflo(yf[i]) + bflo(pf[i]) * hf0) + (bflo(yb[i]) + bflo(pb[i]) * hb0), s1 = (bfhi(yf[i]) + bfhi(pf[i]) * hf1) + (bfhi(yb[i]) + bfhi(pb[i]) * hb1);
            *(unsigned*)(Y2 + row * (2 * DRNN) + n * 128 + cp) = cvt_pk_bf16(s0, s1); }
    }
}

#define GLA_ROW(tp_) (rbase + ((tp_) & rmask) * rmul + ((tp_) >> rshift))
__device__ __forceinline__ void phase_gla_pre(const Args& a, LAS unsigned char* lds) {
    const int tid = threadIdx.x, lane = tid & 63, w = tid >> 6, l15 = lane & 15, lq = lane >> 4;
    unsigned char* ws = a.ws;
    const bf16* PROJ = (const bf16*)(ws + WS_MIX); const float* Z = (const float*)(ws + WS_Z);
    v4u* QF = (v4u*)(ws + WS_QF); v4u* KF = (v4u*)(ws + WS_KF); float* DEC = (float*)(ws + WS_DEC); v4u* VF = (v4u*)(ws + WS_VF); v4u* PF = (v4u*)(ws + WS_PF);
    LAS unsigned short* QS = (LAS unsigned short*)lds;
    LAS unsigned short* KS = (LAS unsigned short*)(lds + 8704);
    LAS unsigned short* KT = (LAS unsigned short*)(lds + 17408);
    LAS unsigned short* PS = (LAS unsigned short*)(lds + 27648);
    LAS float* ZS = (LAS float*)(lds + 30208);
    LAS float* CS = (LAS float*)(lds + 32256);
    LAS unsigned short* VT = (LAS unsigned short*)(lds + 34304);
    const int dk = tid & 127, ig = tid >> 7;
    const int G = gridDim.x;
    const bool hoist = (G & 7) == 0;
    float w2r[16]; float bg = 0.f;
#define GP_W(g_) do { const int hh_ = (g_) & 3, d_ = ((g_) >> 2) & 1; \
        _Pragma("unroll") for (int q = 0; q < 16; ++q) w2r[q] = a.in[I_GW2][(size_t)(d_ * 16 + q) * 512 + hh_ * 128 + dk]; \
        bg = a.in[I_GBG][d_ * 512 + hh_ * 128 + dk]; } while (0)
    unsigned nq[8], nk[8]; float nz = 0.f; v4u nv0 = (v4u){0u, 0u, 0u, 0u}, nv1 = nv0;
#define GP_LOAD(g_) do { const int hh_ = (g_) & 3, d_ = ((g_) >> 2) & 1, cid_ = (g_) >> 3; \
        const int s_ = (cid_ < 128) ? (cid_ >> 3) : 16 + ((cid_ - 128) >> 6), cf_ = (cid_ < 128) ? (cid_ & 7) : ((cid_ - 128) & 63); \
        const int rbase = (s_ < 16) ? s_ * 256 : NPROMPT + (s_ - 16) * 2048, rmask = (s_ < 16) ? 0x7fffffff : 31, rmul = (s_ < 16) ? 1 : 64, rshift = (s_ < 16) ? 30 : 5; \
        _Pragma("unroll") for (int ii = 0; ii < 8; ++ii) { const int i = 8 * ig + ii; const int m = GLA_ROW(32 * cf_ + (d_ ? 31 - i : i)); \
            nq[ii] = PROJ[(size_t)m * PROJ_LD + hh_ * 128 + dk]; nk[ii] = PROJ[(size_t)m * PROJ_LD + 512 + hh_ * 128 + dk]; } \
        { const int iz = tid >> 4; const int mz = GLA_ROW(32 * cf_ + (d_ ? 31 - iz : iz)); nz = Z[(size_t)mz * 32 + d_ * 16 + (tid & 15)]; \
          const int i = tid & 31, cg = tid >> 5; const int m = GLA_ROW(32 * cf_ + (d_ ? 31 - i : i)); \
          const v4u* vp = (const v4u*)(PROJ + (size_t)m * PROJ_LD + 1024 + hh_ * 256 + cg * 16); nv0 = vp[0]; nv1 = vp[1]; } } while (0)
    if ((int)blockIdx.x < 2048) { GP_LOAD((int)blockIdx.x); if (hoist) GP_W((int)blockIdx.x); }
    for (int g = blockIdx.x; g < 2048; g += G) {
        const int hh = g & 3, d = (g >> 2) & 1, cid = g >> 3;
        if (!hoist) GP_W(g);
        unsigned pq[8], pk_[8];
#pragma unroll
        for (int ii = 0; ii < 8; ++ii) { pq[ii] = nq[ii]; pk_[ii] = nk[ii]; }
        { const int iz = tid >> 4; const int i = tid & 31, cg = tid >> 5;
          const v4u v0 = nv0, v1 = nv1;
          ZS[iz * 16 + (tid & 15)] = nz;
          LAS unsigned short* vt = VT + (cg * 16) * 40 + i;
          vt[0 * 40] = (unsigned short)(v0.x & 0xffffu); vt[1 * 40] = (unsigned short)(v0.x >> 16); vt[2 * 40] = (unsigned short)(v0.y & 0xffffu); vt[3 * 40] = (unsigned short)(v0.y >> 16);
          vt[4 * 40] = (unsigned short)(v0.z & 0xffffu); vt[5 * 40] = (unsigned short)(v0.z >> 16); vt[6 * 40] = (unsigned short)(v0.w & 0xffffu); vt[7 * 40] = (unsigned short)(v0.w >> 16);
          vt[8 * 40] = (unsigned short)(v1.x & 0xffffu); vt[9 * 40] = (unsigned short)(v1.x >> 16); vt[10 * 40] = (unsigned short)(v1.y & 0xffffu); vt[11 * 40] = (unsigned short)(v1.y >> 16);
          vt[12 * 40] = (unsigned short)(v1.z & 0xffffu); vt[13 * 40] = (unsigned short)(v1.z >> 16); vt[14 * 40] = (unsigned short)(v1.w & 0xffffu); vt[15 * 40] = (unsigned short)(v1.w >> 16); }
        if (g + G < 2048) GP_LOAD(g + G);
        LDS_BAR();
        float cum[8]; float run = 0.f;
#pragma unroll
        for (int ii = 0; ii < 8; ++ii) { const int i = 8 * ig + ii; float zz = bg;
#pragma unroll
            for (int q4 = 0; q4 < 4; ++q4) { const f32x4 zv = *(const LAS f32x4*)(ZS + i * 16 + 4 * q4);
                zz += zv[0] * w2r[4 * q4] + zv[1] * w2r[4 * q4 + 1] + zv[2] * w2r[4 * q4 + 2] + zv[3] * w2r[4 * q4 + 3]; }
            const float lg = (fminf(zz, 0.f) - __logf(1.0f + __expf(-fabsf(zz)))) * 0.0625f;
            run += lg; cum[ii] = run; }
        CS[ig * 128 + dk] = run;
        LDS_BAR();
        { float pre = 0.f, tot = 0.f;
#pragma unroll
          for (int g2 = 0; g2 < 4; ++g2) { const float v = CS[g2 * 128 + dk]; tot += v; if (g2 < ig) pre += v; }
          float k2[8];
#pragma unroll
          for (int ii = 0; ii < 8; ++ii) { const int i = 8 * ig + ii; const float b = pre + cum[ii];
              const float qv = __uint_as_float(pq[ii] << 16), kv = __uint_as_float(pk_[ii] << 16);
              QS[i * 136 + dk] = (unsigned short)(cvt_pk_bf16(qv * __expf(b), 0.f) & 0xffffu);
              KS[i * 136 + dk] = (unsigned short)(cvt_pk_bf16(kv * __expf(-b), 0.f) & 0xffffu);
              k2[ii] = kv * __expf(tot - b); }
          *(LAS v4u*)(KT + dk * 40 + 8 * ig) = (v4u){cvt_pk_bf16(k2[0], k2[1]), cvt_pk_bf16(k2[2], k2[3]), cvt_pk_bf16(k2[4], k2[5]), cvt_pk_bf16(k2[6], k2[7])};
          if (ig == 0) DEC[(size_t)g * 128 + dk] = __expf(tot); }
        LDS_BAR();
        if (w < 4) {
            const int mi2 = w >> 1, nj = w & 1; f32x4 sc = (f32x4){0.f, 0.f, 0.f, 0.f};
#pragma unroll
            for (int ks = 0; ks < 4; ++ks) { const bf16x8 aq = *(const LAS bf16x8*)(QS + (16 * mi2 + l15) * 136 + 32 * ks + 8 * lq);
                const bf16x8 bk = *(const LAS bf16x8*)(KS + (16 * nj + l15) * 136 + 32 * ks + 8 * lq);
                sc = __builtin_amdgcn_mfma_f32_16x16x32_bf16(aq, bk, sc, 0, 0, 0); }
#pragma unroll
            for (int rg = 0; rg < 4; ++rg) { const int i = 16 * mi2 + 4 * lq + rg, j = 16 * nj + l15;
                PS[i * 40 + j] = (unsigned short)(cvt_pk_bf16((j <= i) ? sc[rg] : 0.f, 0.f) & 0xffffu); }
        }
        { const int mi = w >> 2, ks = w & 3;
          const v2u lo = *(const LAS v2u*)(QS + (16 * mi + l15) * 136 + 32 * ks + 4 * lq), hi = *(const LAS v2u*)(QS + (16 * mi + l15) * 136 + 32 * ks + 16 + 4 * lq);
          QF[((size_t)g * 8 + w) * 64 + lane] = (v4u){lo.x, lo.y, hi.x, hi.y};
          KF[((size_t)g * 8 + w) * 64 + lane] = *(const LAS v4u*)(KT + (16 * w + l15) * 40 + 8 * lq);
          if (d == 0) {
#pragma unroll
              for (int h2 = 0; h2 < 2; ++h2) { const int nb = 2 * w + h2;
                  VF[((size_t)cid * 64 + hh * 16 + nb) * 64 + lane] = *(const LAS v4u*)(VT + (16 * nb + l15) * 40 + 8 * lq); } } }
        LDS_BAR();
        if (w < 2) PF[((size_t)g * 2 + w) * 64 + lane] = *(const LAS v4u*)(PS + (16 * w + l15) * 40 + 8 * lq);
    }
#undef GP_W
#undef GP_LOAD
}

__device__ __forceinline__ unsigned rot16(unsigned x) { return (x >> 16) | (x << 16); }
__device__ __forceinline__ void phase_gla_scan(const Args& a, LAS unsigned char* lds) {
    const int tid = threadIdx.x, lane = tid & 63, w = tid >> 6, l15 = lane & 15, lq = lane >> 4;
    unsigned char* ws = a.ws;
    const v4u* QF = (const v4u*)(ws + WS_QF); const v4u* KF = (const v4u*)(ws + WS_KF); const float* DEC = (const float*)(ws + WS_DEC); const v4u* VF = (const v4u*)(ws + WS_VF); const v4u* PF = (const v4u*)(ws + WS_PF);
    const int G = gridDim.x, b = blockIdx.x;
    LAS v4u* RING = (LAS v4u*)lds;
    for (int k = 0;; ++k) {
        const int it = (k & 1) ? k * G + (G - 1 - b) : k * G + b;
        if (it >= 64 + 256) break;
        const bool lng = it < 64; const int r = lng ? it : it - 64;
        const int hh = lng ? ((r >> 2) & 3) : ((r >> 1) & 3), d = lng ? ((r >> 4) & 1) : ((r >> 3) & 1), sq = lng ? (r >> 5) : (r >> 4);
        const bool act = lng ? (w < 4) : true;
        const int sl = lng ? (r & 3) * 4 + (w & 3) : (r & 1) * 8 + w, s = lng ? 16 + sq : sq;
        const int nch = lng ? 64 : 8, cid0 = lng ? 128 + sq * 64 : sq * 8;
        const int rbase = (s < 16) ? s * 256 : NPROMPT + (s - 16) * 2048, rmask = (s < 16) ? 0x7fffffff : 31, rmul = (s < 16) ? 1 : 64, rshift = (s < 16) ? 30 : 5;
        bf16* O = (bf16*)(ws + WS_P) + (size_t)d * TOK * DM + hh * 256 + 16 * sl + l15;
        const int vlane = d ? (l15 + 16 * (3 - lq)) : lane;
        bf16* op[2][4];
#pragma unroll
        for (int mi = 0; mi < 2; ++mi)
#pragma unroll
            for (int rg = 0; rg < 4; ++rg) { const int i = 16 * mi + 4 * lq + rg; const int ip = d ? 31 - i : i; op[mi][rg] = O + (size_t)(rbase + ip * ((s < 16) ? 1 : 64)) * DM; }
        const size_t cstride = (size_t)((s < 16) ? 32 : 1) * DM;
        f32x4 sacc[8];
#pragma unroll
        for (int f = 0; f < 8; ++f) {
            if (lng) { const float* sp = a.in[I_SGLA] + (size_t)((sq * 2 + d) * 4 + hh) * 32768 + (size_t)(16 * f + 4 * lq) * 256 + 16 * sl + l15;
                sacc[f] = (f32x4){sp[0], sp[256], sp[512], sp[768]}; }
            else sacc[f] = (f32x4){0.f, 0.f, 0.f, 0.f};
        }
        v4u qn[2][8], vn[2], kst[2], dsx[2], pn[2][2];
        dsx[0] = (v4u){0u, 0u, 0u, 0u}; dsx[1] = (v4u){0u, 0u, 0u, 0u};
#pragma unroll
        for (int u = 0; u < 2; ++u) { vn[u] = (v4u){0u, 0u, 0u, 0u}; pn[u][0] = vn[u]; pn[u][1] = vn[u];
#pragma unroll
            for (int q = 0; q < 8; ++q) qn[u][q] = vn[u]; }
#define GS_LOAD(u_, c_) do { const int cid_ = cid0 + (d ? nch - 1 - (c_) : (c_)); const size_t g_ = ((size_t)cid_ * 2 + d) * 4 + hh; \
        kst[u_] = KF[g_ * 512 + tid]; if (tid < 32) dsx[u_] = *(const v4u*)(DEC + g_ * 128 + 4 * tid); \
        if (act) { _Pragma("unroll") for (int q = 0; q < 8; ++q) qn[u_][q] = QF[(g_ * 8 + q) * 64 + lane]; \
        vn[u_] = VF[((size_t)cid_ * 64 + hh * 16 + sl) * 64 + vlane]; \
        pn[u_][0] = PF[(g_ * 2 + 0) * 64 + lane]; pn[u_][1] = PF[(g_ * 2 + 1) * 64 + lane]; } } while (0)
#define GS_STAGE(slot_, u_) do { RING[(slot_) * 544 + tid] = kst[u_]; if (tid < 32) RING[(slot_) * 544 + 512 + tid] = dsx[u_]; } while (0)
        GS_LOAD(0, 0); GS_LOAD(1, 1);
        GS_STAGE(0, 0);
        LDS_BAR();
        for (int c0 = 0; c0 < nch; c0 += 2) {
#pragma unroll
          for (int u = 0; u < 2; ++u) {
            const int c = c0 + u;
            const int cid = cid0 + (d ? nch - 1 - c : c); const int cf = cid - cid0;
            if (!act) { if (c + 2 < nch) GS_LOAD(u, c + 2); if (c + 1 < nch) GS_STAGE((c + 1) & 1, u ^ 1); LDS_BAR(); continue; }
            v4u qf[8]; f32x4 o[2];
#pragma unroll
            for (int q = 0; q < 8; ++q) qf[q] = qn[u][q];
            v4u vf = vn[u]; const v4u pf0 = pn[u][0], pf1 = pn[u][1];
            if (d) vf = (v4u){rot16(vf.w), rot16(vf.z), rot16(vf.y), rot16(vf.x)};
            const bf16x8 vb = __builtin_bit_cast(bf16x8, vf);
            if (c + 2 < nch) GS_LOAD(u, c + 2);
            o[0] = __builtin_amdgcn_mfma_f32_16x16x32_bf16(__builtin_bit_cast(bf16x8, pf0), vb, (f32x4){0.f, 0.f, 0.f, 0.f}, 0, 0, 0);
            o[1] = __builtin_amdgcn_mfma_f32_16x16x32_bf16(__builtin_bit_cast(bf16x8, pf1), vb, (f32x4){0.f, 0.f, 0.f, 0.f}, 0, 0, 0);
            const LAS v4u* slot = RING + (c & 1) * 544;
#pragma unroll
            for (int ks = 0; ks < 4; ++ks) {
                v4u sb; sb.x = cvt_pk_bf16(sacc[2 * ks][0], sacc[2 * ks][1]); sb.y = cvt_pk_bf16(sacc[2 * ks][2], sacc[2 * ks][3]);
                sb.z = cvt_pk_bf16(sacc[2 * ks + 1][0], sacc[2 * ks + 1][1]); sb.w = cvt_pk_bf16(sacc[2 * ks + 1][2], sacc[2 * ks + 1][3]);
                const bf16x8 sbv = __builtin_bit_cast(bf16x8, sb);
                o[0] = __builtin_amdgcn_mfma_f32_16x16x32_bf16(__builtin_bit_cast(bf16x8, qf[ks]), sbv, o[0], 0, 0, 0);
                o[1] = __builtin_amdgcn_mfma_f32_16x16x32_bf16(__builtin_bit_cast(bf16x8, qf[4 + ks]), sbv, o[1], 0, 0, 0);
            }
#pragma unroll
            for (int mi = 0; mi < 2; ++mi)
#pragma unroll
                for (int rg = 0; rg < 4; ++rg) op[mi][rg][(size_t)cf * cstride] = (bf16)(cvt_pk_bf16(o[mi][rg], 0.f) & 0xffffu);
#pragma unroll
            for (int f = 0; f < 8; ++f) { const v4u kfv = slot[f * 64 + lane]; const f32x4 dec = *(const LAS f32x4*)((const LAS float*)(slot + 512) + 16 * f + 4 * lq);
                sacc[f] = sacc[f] * dec; sacc[f] = __builtin_amdgcn_mfma_f32_16x16x32_bf16(__builtin_bit_cast(bf16x8, kfv), vb, sacc[f], 0, 0, 0); }
            if (c + 1 < nch) GS_STAGE((c + 1) & 1, u ^ 1);
            LDS_BAR();
          }
        }
#undef GS_LOAD
#undef GS_STAGE
        if (!lng) {
#pragma unroll
            for (int f = 0; f < 8; ++f) { float* dp = a.out + OUT_GLA + (size_t)((s * 2 + d) * 4 + hh) * 32768 + (size_t)(16 * f + 4 * lq) * 256 + 16 * sl + l15;
                dp[0] = sacc[f][0]; dp[256] = sacc[f][1]; dp[512] = sacc[f][2]; dp[768] = sacc[f][3]; }
        }
    }
}

__device__ __forceinline__ void phase_gla_norm(const Args& a) {
    const int tid = threadIdx.x, lane = tid & 63, wave = tid >> 6;
    const int gw = blockIdx.x * 8 + wave, NGW = gridDim.x * 8;
    const bf16* Of = (const bf16*)(a.ws + WS_P); const bf16* Ob = Of + (size_t)TOK * DM;
    const bf16* PROJ = (const bf16*)(a.ws + WS_MIX); bf16* AO = (bf16*)(a.ws + WS_XN);
    const bool aff = (gridDim.x == 256);
    const int affm0 = 1024 * (blockIdx.x & 7) + 32 * (blockIdx.x >> 3) + 4 * wave;
    for (int m0 = aff ? affm0 : gw * 4; m0 < TOK; m0 += aff ? TOK : NGW * 4) {
        f32x4 gn[4];
#pragma unroll
        for (int j = 0; j < 4; ++j) gn[j] = ((const f32x4*)a.in[I_GNORM])[lane + 64 * j];
#pragma unroll
        for (int r = 0; r < 4; ++r) {
            const int m = m0 + r;
#pragma unroll
            for (int j = 0; j < 4; ++j) {
                const v2u of = ((const v2u*)(Of + (size_t)m * DM))[lane + 64 * j], ob = ((const v2u*)(Ob + (size_t)m * DM))[lane + 64 * j];
                const f32x4 v = (f32x4){bflo(of.x) + bflo(ob.x), bfhi(of.x) + bfhi(ob.x), bflo(of.y) + bflo(ob.y), bfhi(of.y) + bfhi(ob.y)};
                const float ss = wave_sum((v[0] * v[0] + v[1] * v[1]) + (v[2] * v[2] + v[3] * v[3]));
                const float rstd = 1.0f / sqrtf(ss * (1.0f / 256.0f) + EPS);
                const v2u sr = *(const v2u*)(PROJ + (size_t)m * PROJ_LD + 2048 + 256 * j + 4 * lane);
                v2u wv; wv.x = cvt_pk_bf16(v[0] * rstd * gn[j][0] * bflo(sr.x), v[1] * rstd * gn[j][1] * bfhi(sr.x));
                wv.y = cvt_pk_bf16(v[2] * rstd * gn[j][2] * bflo(sr.y), v[3] * rstd * gn[j][3] * bfhi(sr.y));
                ((v2u*)(AO + (size_t)m * DM))[lane + 64 * j] = wv;
            }
        }
    }
}

#define XB_TMO      128
#define XB_XCNT(j)  (256  + 64 * (j))
#define XB_XSUB(j)  (1280 + 64 * (j))
#define XB_XGEN(j)  (2304 + 64 * (j))
#define XB_TOP      3328
#define XB_TOPGEN   3392
#define XCD_BAR_WORDS 3456
#define XB_SPIN_CAP (1u << 18)
__device__ __forceinline__ unsigned xb_ld(unsigned* p)              { return __hip_atomic_load(p, __ATOMIC_RELAXED, __HIP_MEMORY_SCOPE_AGENT); }
__device__ __forceinline__ unsigned xb_add(unsigned* p, unsigned v) { return __hip_atomic_fetch_add(p, v, __ATOMIC_RELAXED, __HIP_MEMORY_SCOPE_AGENT); }
__device__ __forceinline__ unsigned xb_xcc_id() { return (unsigned)__builtin_amdgcn_s_getreg((3 << 11) | 20) & 0xFu; }
#define XB_SPIN(cond, bar) do { unsigned _sp = 0; while (cond) { __builtin_amdgcn_s_sleep(1); \
    if ((++_sp & 255u) == 0u) { if (xb_ld(&(bar)[XB_TMO])) break; if (_sp > XB_SPIN_CAP) { atomicAdd(&(bar)[XB_TMO], 1u); break; } } } } while (0)
struct XcdBarrier { unsigned* bar; unsigned x; volatile LAS unsigned* st; };
__device__ __forceinline__ XcdBarrier xcd_barrier_post(unsigned* bar, volatile LAS unsigned* st) {
    XcdBarrier b; b.bar = bar; b.x = xb_xcc_id(); b.st = st;
    if (threadIdx.x == 0) (void)xb_add(&bar[XB_XCNT(b.x)], 1u);
    return b;
}
__device__ __forceinline__ void xcd_barrier_complete(unsigned* bar, unsigned x, unsigned& nloc, unsigned& nx) {
    const unsigned G = gridDim.x * gridDim.y * gridDim.z;
    unsigned sum, cnt, mine, sp = 0u;
    for (;;) {
        sum = 0u; cnt = 0u; mine = 0u;
#pragma unroll
        for (unsigned j = 0; j < 16; ++j) { const unsigned c = xb_ld(&bar[XB_XCNT(j)]); sum += c; cnt += (c > 0u) ? 1u : 0u; mine = (j == x) ? c : mine; }
        if (sum == G) break;
        __builtin_amdgcn_s_sleep(1);
        if ((++sp & 255u) == 0u) { if (xb_ld(&bar[XB_TMO])) break; if (sp > XB_SPIN_CAP) { atomicAdd(&bar[XB_TMO], 1u); break; } }
    }
    nloc = mine > 0u ? mine : 1u; nx = cnt > 0u ? cnt : 1u;
}
__device__ __forceinline__ void xcd_barrier(const XcdBarrier& b) {
    asm volatile("s_waitcnt vmcnt(0)" ::: "memory");
    __syncthreads();
    if (threadIdx.x == 0) {
        unsigned* bar = b.bar;
        __builtin_amdgcn_s_waitcnt(0);
        unsigned nloc = b.st[0], nx = b.st[1];
        if (nloc == 0u) { xcd_barrier_complete(bar, b.x, nloc, nx); b.st[0] = nloc; b.st[1] = nx; }
        const unsigned old = xb_add(&bar[XB_XSUB(b.x)], 1u);
        const unsigned gen = old / nloc;
        if (old + 1u == (gen + 1u) * nloc) {
            __builtin_amdgcn_fence(__ATOMIC_RELEASE, "agent");
            asm volatile("s_waitcnt vmcnt(0)" ::: "memory");
            const unsigned og = xb_add(&bar[XB_TOP], 1u);
            const unsigned tg = og / nx;
            if (og + 1u == (tg + 1u) * nx) xb_add(&bar[XB_TOPGEN], 1u);
            else XB_SPIN(xb_ld(&bar[XB_TOPGEN]) == tg, bar);
            __builtin_amdgcn_fence(__ATOMIC_ACQUIRE, "agent");
            xb_add(&bar[XB_XGEN(b.x)], 1u);
            asm volatile("s_waitcnt vmcnt(0)" ::: "memory");
        } else {
            XB_SPIN(xb_ld(&bar[XB_XGEN(b.x)]) == gen, bar);
            __builtin_amdgcn_fence(__ATOMIC_ACQUIRE, "agent");
            asm volatile("s_waitcnt vmcnt(0)" ::: "memory");
        }
    }
    __syncthreads();
}

#define XL_SUB(j)  (3600 + 16 * (j))
#define XL_GEN(j)  (3608 + 16 * (j))
#define XL_SLOT    3560
#define XL_BAD     3592
__device__ __forceinline__ void xcd_barrier_local(unsigned* bar, unsigned x, unsigned nloc) {
    asm volatile("s_waitcnt vmcnt(0)" ::: "memory");
    __syncthreads();
    if (threadIdx.x == 0) {
        __builtin_amdgcn_s_waitcnt(0);
        const unsigned old = xb_add(&bar[XL_SUB(x)], 1u);
        const unsigned gen = old / nloc;
        if (old + 1u == (gen + 1u) * nloc) xb_add(&bar[XL_GEN(x)], 1u);
        else XB_SPIN(xb_ld(&bar[XL_GEN(x)]) == gen, bar);
        __builtin_amdgcn_fence(__ATOMIC_ACQUIRE, "agent");
        asm volatile("s_waitcnt vmcnt(0)" ::: "memory");
    }
    __syncthreads();
}

constexpr int LDS_BYTES = pg8::STAGE_BYTES + 64;
constexpr int N_PHASES = 25;

__global__ void __launch_bounds__(512, 2) fwd_megakernel(Args args) {
    extern __shared__ __attribute__((aligned(16))) unsigned char lds_raw[];
    LAS unsigned char* lds = (LAS unsigned char*)lds_raw;
    cg::grid_group grid = cg::this_grid();
    unsigned char* ws = args.ws;
    const int lo = args.ph_lo, hi = args.ph_hi;
    const int G = gridDim.x, bx = blockIdx.x;
    unsigned* barw = (unsigned*)ws;
    volatile LAS unsigned* bst = (volatile LAS unsigned*)(lds + pg8::STAGE_BYTES);
    if (threadIdx.x == 0) { bst[0] = 0u; bst[1] = 0u; }
    __syncthreads();
    XcdBarrier xbar = xcd_barrier_post(barw, bst);
    if (threadIdx.x == 0) {
        const unsigned prev = atomicCAS(&barw[XL_SLOT + (blockIdx.x & 7u)], 0u, xbar.x + 1u);
        if (prev != 0u && prev != xbar.x + 1u) (void)xb_add(&barw[XL_BAD], 1u);
    }
    bool local_ok = false;
    if (hi > 1000000) grid.sync();
#define IN(k) (lo <= (k) && (k) < hi)
#define DUP(k) ((DUP_MASK >> (k)) & 1u)
#define RUN(k, ...) do { if (IN(k)) { __VA_ARGS__; if (DUP(k)) { __syncthreads(); __VA_ARGS__; } } } while (0)
#define SEAM(k) do { if (IN(k) && IN((k) + 1)) { xcd_barrier(xbar); } } while (0)
#define LSEAM(k) do { if (IN(k) && IN((k) + 1)) { if (local_ok) xcd_barrier_local(barw, blockIdx.x & 7u, (unsigned)G >> 3); else xcd_barrier(xbar); } } while (0)

#define GEMM_FFN_IN(mi) do { pg8::Gemm g{(const bf16*)(ws + WS_XN), (const bf16*)(ws + WS_WFI) + (size_t)(mi) * 5632 * 1024, 1024, 1024, 1024, 0, 0}; \
        pg8::Order S; S.init(TOK, 5632, 1, G, bx); pg8::EpiSwiglu E{(bf16*)(ws + WS_HID)}; pg8::gemm_phase<pg8::EpiSwiglu>(lds, g, S, E); } while (0)
#define GEMM_FFN_OUT(mi) do { pg8::Gemm g{(const bf16*)(ws + WS_HID), (const bf16*)(ws + WS_WFO) + (size_t)(mi) * 1024 * 2816, 1408, 2816, 2816, 1408, 1408}; \
        pg8::Order S; S.init(TOK, 1024, 2, G, bx); pg8::EpiPart E{(bf16*)(ws + WS_P)}; pg8::gemm_phase<pg8::EpiPart>(lds, g, S, E); } while (0)

    RUN(0, phase_prep(args, lds);); SEAM(0);
    local_ok = (G == 256) && (xb_ld(&barw[XL_BAD]) == 0u);
    RUN(1, phase_combine(args, 1, 0, 0, 0, 0.f, 0, 0);); LSEAM(1);
    RUN(2, GEMM_FFN_IN(0); if (G == 256 && bx >= 192) ada_items(args, lds, 144 + (bx - 192), 64, 216);); LSEAM(2);
    RUN(3, GEMM_FFN_OUT(0);); LSEAM(3);
    RUN(4, phase_combine(args, 0, 0, 0, 0, 0.5f, 0, 1);); LSEAM(4);
    RUN(5, { pg8::Gemm g{(const bf16*)(ws + WS_XN), (const bf16*)(ws + WS_WRI), 1024, 1024, 1024, 0, 0};
        pg8::Order S; S.init(TOK, 2560, 1, G, bx); pg8::EpiRgIn E{(bf16*)(ws + WS_MIX), (bf16*)(ws + WS_P)}; pg8::gemm_phase<pg8::EpiRgIn>(lds, g, S, E);
        if (G == 256 && bx >= 64) { const int gw_ = (bx - 64) * 8 + (int)(threadIdx.x >> 6); convert_weights(args, lds, 1, gw_, 192 * 8, 0x7fffffff, gw_, 192 * 8); } }); SEAM(5);

    RUN(6, phase_rg(args, lds);); SEAM(6);
    RUN(7, phase_rg_fix(args);); SEAM(7);
    RUN(8, { pg8::Gemm g{(const bf16*)(ws + WS_HID), (const bf16*)(ws + WS_WRO), 640, 2560, 1280, 640, 640};
        pg8::Order S; S.init(TOK, 1024, 2, G, bx); pg8::EpiPart E{(bf16*)(ws + WS_P)}; pg8::gemm_phase<pg8::EpiPart>(lds, g, S, E); }); LSEAM(8);
    RUN(9, phase_combine(args, 0, 0, 0, 1, 1.0f, 0, 2);); LSEAM(9);
    RUN(10, GEMM_FFN_IN(1); if (G == 256 && bx >= 192) ada_items(args, lds, 216 + (bx - 192), 64, 288);); LSEAM(10);
    RUN(11, GEMM_FFN_OUT(1);); SEAM(11);
    RUN(12, phase_combine(args, 0, 0, 0, 2, 0.5f, 1, 0);); LSEAM(12);
    RUN(13, GEMM_FFN_IN(2);); LSEAM(13);
    RUN(14, GEMM_FFN_OUT(2);); LSEAM(14);
    RUN(15, phase_combine(args, 0, 0, 1, 0, 0.5f, 1, 1);); LSEAM(15);
    RUN(16, { pg8::Gemm g{(const bf16*)(ws + WS_XN), (const bf16*)(ws + WS_WGI), 1024, 1024, 1024, 0, 0};
        pg8::Order S; S.init(TOK, GLA_NP, 1, G, bx); pg8::EpiGlaIn E{(bf16*)(ws + WS_MIX), (float*)(ws + WS_Z)}; pg8::gemm_phase<pg8::EpiGlaIn>(lds, g, S, E); }); SEAM(16);
    RUN(17, phase_gla_pre(args, lds);); SEAM(17);
    RUN(18, phase_gla_scan(args, lds); if (G == 256 && bx >= 64) { __syncthreads(); const int gw_ = (bx - 64) * 8 + (int)(threadIdx.x >> 6); convert_weights(args, lds, 2, gw_, 192 * 8, 0x7fffffff, gw_, 192 * 8); }); SEAM(18);
    RUN(19, phase_gla_norm(args);); LSEAM(19);
    RUN(20, { pg8::Gemm g{(const bf16*)(ws + WS_XN), (const bf16*)(ws + WS_WGO), 512, 1024, 1024, 512, 512};
        pg8::Order S; S.init(TOK, 1024, 2, G, bx); pg8::EpiPart E{(bf16*)(ws + WS_P)}; pg8::gemm_phase<pg8::EpiPart>(lds, g, S, E); }); LSEAM(20);
    RUN(21, phase_combine(args, 0, 0, 1, 1, 1.0f, 1, 2);); LSEAM(21);
    RUN(22, GEMM_FFN_IN(3);); LSEAM(22);
    RUN(23, GEMM_FFN_OUT(3);); LSEAM(23);
    RUN(24, phase_combine(args, 0, 1, 1, 2, 0.5f, 0, 0););
#undef IN
#undef SEAM
#undef LSEAM
}

extern "C" void kernel_launch(void* const* d_in, const int* in_sizes, int n_in, void* d_out, int out_size, void* d_ws, size_t ws_size, hipStream_t stream) {
    static int grid = 0;
    if (grid == 0) {
        if (n_in != 26 || ws_size < WS_END) { fprintf(stderr, "kernel_launch: expected 26 inputs and >= %zu bytes of workspace (got %d, %zu)\n", (size_t)WS_END, n_in, ws_size); grid = -1; return; }
        int dev = 0, cus = 0, per_cu = 0;
        if (hipGetDevice(&dev) != hipSuccess || hipDeviceGetAttribute(&cus, hipDeviceAttributeMultiprocessorCount, dev) != hipSuccess) { grid = -1; return; }
        if (hipFuncSetAttribute((const void*)fwd_megakernel, hipFuncAttributeMaxDynamicSharedMemorySize, LDS_BYTES) != hipSuccess) { fprintf(stderr, "kernel_launch: hipFuncSetAttribute failed\n"); grid = -1; return; }
        if (hipOccupancyMaxActiveBlocksPerMultiprocessor(&per_cu, (const void*)fwd_megakernel, 512, LDS_BYTES) != hipSuccess || per_cu < 1) { fprintf(stderr, "kernel_launch: occupancy query failed (%d)\n", per_cu); (void)hipGetLastError(); grid = -1; return; }
        grid = cus;
    }
    if (grid < 0) return;
    if (hipMemsetAsync(d_ws, 0, 16384, stream) != hipSuccess) { fprintf(stderr, "kernel_launch: hipMemsetAsync of the barrier words failed\n"); return; }
    Args a{};
    for (int i = 0; i < 26; ++i) a.in[i] = (const float*)d_in[i];
    a.out = (float*)d_out; a.ws = (unsigned char*)d_ws;
    a.ph_lo = 0; a.ph_hi = N_PHASES; void* kargs[] = {&a};
    hipError_t e = hipLaunchCooperativeKernel((const void*)fwd_megakernel, dim3(grid), dim3(512), kargs, LDS_BYTES, stream);
    if (e != hipSuccess) fprintf(stderr, "kernel_launch: cooperative launch failed: %s (grid %d)\n", hipGetErrorString(e), grid);
}
```
